# Optimizing an MI355X kernel written in HIP

```python
import math
import jax, jax.numpy as jnp
from jax import lax
import numpy as np

D_MODEL = 1024
BATCH = 8
SEQ = 2048
DEPTH = 4

N_HEADS = 8
QK_NOPE = 128
QK_ROPE = 64
V_HEAD = 128
Q_LORA = 384
KV_LORA = 256
ATTN_WIDTH = N_HEADS * V_HEAD
ROPE_THETA = 10000.0
Q_BLOCK = 128
CONV_WIDTH = D_MODEL
CONV_K = 31
RMS_EPS = 1e-6
LN_EPS = 1e-5
N_MIXERS = 2
N_MLA = (DEPTH + 1) // 2
N_CONV = DEPTH // 2
MLA_IN = Q_LORA + KV_LORA + QK_ROPE + ATTN_WIDTH

kernel_name = "hybrid_mla_conformer_conv_gated"


def rmsnorm(x, g):
    xf = x.astype(jnp.float32)
    y = xf * lax.rsqrt(jnp.mean(xf * xf, axis=-1, keepdims=True) + RMS_EPS)
    return (y * g.astype(jnp.float32)).astype(x.dtype)


def layernorm(x, g, b):
    xf = x.astype(jnp.float32)
    mu = jnp.mean(xf, axis=-1, keepdims=True)
    var = jnp.mean(jnp.square(xf - mu), axis=-1, keepdims=True)
    y = (xf - mu) * lax.rsqrt(var + LN_EPS)
    return (y * g.astype(jnp.float32) + b.astype(jnp.float32)).astype(x.dtype)


def rope_tables(positions):
    inv_freq = ROPE_THETA ** (-jnp.arange(0, QK_ROPE, 2, dtype=jnp.float32) / QK_ROPE)
    ang = positions.astype(jnp.float32)[..., None] * inv_freq
    return jnp.cos(ang), jnp.sin(ang)


def apply_rope(x, cos, sin):
    xf = x.astype(jnp.float32)
    x1, x2 = jnp.split(xf, 2, axis=-1)
    out = jnp.concatenate([x1 * cos - x2 * sin, x2 * cos + x1 * sin], axis=-1)
    return out.astype(x.dtype)


def causal_block_attention(q, k, v):
    B, S, H, D = q.shape
    nb = S // Q_BLOCK
    scale = 1.0 / math.sqrt(D)
    kf = k.astype(jnp.float32)
    kpos = jnp.arange(S)
    qb = q.reshape(B, nb, Q_BLOCK, H, D).transpose(1, 0, 2, 3, 4)

    def one_block(args):
        qi, i = args
        qpos = i * Q_BLOCK + jnp.arange(Q_BLOCK)
        s = jnp.einsum('bqhd,bkhd->bhqk', qi.astype(jnp.float32), kf) * scale
        mask = kpos[None, :] <= qpos[:, None]
        s = jnp.where(mask[None, None], s, -jnp.inf)
        p = jax.nn.softmax(s, axis=-1).astype(v.dtype)
        return jnp.einsum('bhqk,bkhd->bqhd', p, v)

    out = lax.map(one_block, (qb, jnp.arange(nb)))
    return out.transpose(1, 0, 2, 3, 4).reshape(B, S, H, v.shape[-1])


def mla_mixer(h, cos, sin, w_in, q_norm_g, w_qb, kv_norm_g, w_kvb, w_out):
    B, S, _ = h.shape
    z = h @ w_in
    q_lat, kv_lat, k_pe, gate = jnp.split(
        z, [Q_LORA, Q_LORA + KV_LORA, Q_LORA + KV_LORA + QK_ROPE], axis=-1)
    q = (rmsnorm(q_lat, q_norm_g) @ w_qb).reshape(B, S, N_HEADS, QK_NOPE + QK_ROPE)
    q_nope, q_pe = jnp.split(q, [QK_NOPE], axis=-1)
    kv = (rmsnorm(kv_lat, kv_norm_g) @ w_kvb).reshape(B, S, N_HEADS, QK_NOPE + V_HEAD)
    k_nope, v = jnp.split(kv, [QK_NOPE], axis=-1)
    q_pe = apply_rope(q_pe, cos[:, :, None, :], sin[:, :, None, :])
    k_pe = apply_rope(k_pe, cos, sin)
    q = jnp.concatenate([q_nope, q_pe], axis=-1)
    k = jnp.concatenate(
        [k_nope, jnp.broadcast_to(k_pe[:, :, None, :], (B, S, N_HEADS, QK_ROPE))], axis=-1)
    o = causal_block_attention(q, k, v).reshape(B, S, ATTN_WIDTH)
    return (o * jax.nn.silu(gate)) @ w_out


def conv_mixer(h, w_in, b_in, dw_w, dw_b, ln_g, ln_b, w_out, b_out):
    z = h @ w_in + b_in
    a, b, gate = jnp.split(z, 3, axis=-1)
    u = a * jax.nn.sigmoid(b)
    u = lax.conv_general_dilated(
        u, dw_w[:, None, :], window_strides=(1,), padding=[(CONV_K - 1, 0)],
        dimension_numbers=('NWC', 'WIO', 'NWC'),
        feature_group_count=CONV_WIDTH) + dw_b
    u = jax.nn.silu(layernorm(u, ln_g, ln_b))
    return (u * jax.nn.silu(gate)) @ w_out + b_out


def setup_inputs(seed: int = 0) -> dict:
    key = jax.random.key(seed)
    ks = jax.random.split(key, 24)
    f32 = jnp.float32

    def w(k, shape, fan_in):
        return jax.random.normal(k, shape, f32) * (fan_in ** -0.5)

    def gain(k, shape):
        return 1.0 + 0.02 * jax.random.normal(k, shape, f32)

    def bias(k, shape):
        return 0.02 * jax.random.normal(k, shape, f32)

    x = jax.random.normal(ks[0], (BATCH, SEQ, D_MODEL), f32)
    offset = jax.random.randint(ks[1], (BATCH, 1), 0, 1024, dtype=jnp.int32)
    positions = offset + jnp.arange(SEQ, dtype=jnp.int32)[None, :]
    return {
        "x": x,
        "positions": positions,
        "final_norm_g": gain(ks[2], (D_MODEL,)),
        "mla_norm_g": gain(ks[3], (N_MLA, D_MODEL)),
        "mla_w_in": w(ks[4], (N_MLA, D_MODEL, MLA_IN), D_MODEL),
        "mla_q_norm_g": gain(ks[5], (N_MLA, Q_LORA)),
        "mla_w_qb": w(ks[6], (N_MLA, Q_LORA, N_HEADS * (QK_NOPE + QK_ROPE)), Q_LORA),
        "mla_kv_norm_g": gain(ks[7], (N_MLA, KV_LORA)),
        "mla_w_kvb": w(ks[8], (N_MLA, KV_LORA, N_HEADS * (QK_NOPE + V_HEAD)), KV_LORA),
        "mla_w_out": w(ks[9], (N_MLA, ATTN_WIDTH, D_MODEL), ATTN_WIDTH),
        "conv_norm_g": gain(ks[10], (N_CONV, D_MODEL)),
        "conv_w_in": w(ks[11], (N_CONV, D_MODEL, 3 * CONV_WIDTH), D_MODEL),
        "conv_b_in": bias(ks[12], (N_CONV, 3 * CONV_WIDTH)),
        "conv_dw_w": w(ks[13], (N_CONV, CONV_K, CONV_WIDTH), CONV_K),
        "conv_dw_b": bias(ks[14], (N_CONV, CONV_WIDTH)),
        "conv_ln_g": gain(ks[15], (N_CONV, CONV_WIDTH)),
        "conv_ln_b": bias(ks[16], (N_CONV, CONV_WIDTH)),
        "conv_w_out": w(ks[17], (N_CONV, CONV_WIDTH, D_MODEL), CONV_WIDTH),
        "conv_b_out": bias(ks[18], (N_CONV, D_MODEL)),
    }


def reference(x, positions, final_norm_g,
              mla_norm_g, mla_w_in, mla_q_norm_g, mla_w_qb, mla_kv_norm_g, mla_w_kvb, mla_w_out,
              conv_norm_g, conv_w_in, conv_b_in, conv_dw_w, conv_dw_b, conv_ln_g, conv_ln_b,
              conv_w_out, conv_b_out):
    cos, sin = rope_tables(positions)
    for i in range(DEPTH):
        j = i // N_MIXERS
        if i % N_MIXERS == 0:
            h = rmsnorm(x, mla_norm_g[j])
            x = x + mla_mixer(h, cos, sin, mla_w_in[j], mla_q_norm_g[j], mla_w_qb[j],
                              mla_kv_norm_g[j], mla_w_kvb[j], mla_w_out[j])
        else:
            h = rmsnorm(x, conv_norm_g[j])
            x = x + conv_mixer(h, conv_w_in[j], conv_b_in[j], conv_dw_w[j], conv_dw_b[j],
                               conv_ln_g[j], conv_ln_b[j], conv_w_out[j], conv_b_out[j])
    return rmsnorm(x, final_norm_g)
```

```cpp
#include <hip/hip_runtime.h>
#include <hip/hip_bf16.h>
#include <cstdio>
#include <cstdint>

#ifndef MK_STEPWISE
#define MK_STEPWISE 0
#endif

constexpr int D_MODEL = 1024, BATCH = 8, SEQ = 2048, MTOK = BATCH * SEQ;
constexpr int N_HEADS = 8, QK_NOPE = 128, QK_ROPE = 64, V_HEAD = 128, Q_LORA = 384, KV_LORA = 256;
constexpr int MLA_IN = Q_LORA + KV_LORA + QK_ROPE + N_HEADS * V_HEAD;
constexpr int ZP = 1792;
constexpr int Z_KPE = 384, Z_KV = 512, Z_GATE = 768;
constexpr int QP = N_HEADS * (QK_NOPE + QK_ROPE);
constexpr int KVP = N_HEADS * (QK_NOPE + V_HEAD);
constexpr int CONV_K = 31, CONV_IN = 3 * D_MODEL;
constexpr float RMS_EPS = 1e-6f, LN_EPS = 1e-5f;

namespace pg8 {
#define PG8_LAS __attribute__((address_space(3)))
typedef unsigned short bf16_t;
typedef short bf16x8 __attribute__((ext_vector_type(8)));
typedef float f32x4 __attribute__((ext_vector_type(4)));
typedef unsigned u32x4 __attribute__((ext_vector_type(4)));
typedef unsigned u32x2 __attribute__((ext_vector_type(2)));
constexpr int BM = 256, BK = 64, HALF = 128, HTB = HALF * BK * 2  , STAGE_BYTES = 8 * HTB, NXCD = 8, WGM = 8;

__host__ __device__ __forceinline__ int lds_byte(int r, int c) { const int st = (r >> 4) * 2 + (c >> 5), rr = r & 15, cc = c & 31, ob = rr * 64 + cc * 2; return st * 1024 + (ob ^ (((ob >> 9) & 1) << 5)); }
__host__ __device__ __forceinline__ void stage_rc(int b, int& R, int& C) { const int st = b / 1024, sb = b % 1024, swz = sb ^ (((sb >> 9) & 1) << 5); R = (st >> 1) * 16 + swz / 64; C = (st & 1) * 32 + (swz % 64) / 2; }
__host__ __device__ __forceinline__ int perm32(int rho) { const int n = rho >> 4, i = rho & 15; return 8 * (i >> 2) + 4 * n + (i & 3); }

struct Unit { int pm, pn; };
struct Gemm { const bf16_t* A; const bf16_t* Bt; int M, N, K, lda; };

struct StaticOrder {
    int nM, nN, nwg, G, c;
    __host__ __device__ void init(int M, int N, int G_, int c_) { nM = M / BM; nN = N / BM; nwg = nM * nN; G = G_; c = c_; }
    __host__ __device__ bool next(int i, Unit& u) const {
        const long L = (long)i * G + c; if (L >= nwg) return false;
        int wgid = (int)L; { const int q = nwg / NXCD, r = nwg % NXCD, xcd = wgid % NXCD, off = wgid / NXCD; wgid = (xcd < r ? xcd * (q + 1) : r * (q + 1) + (xcd - r) * q) + off; }
        const int nig = WGM * nN, gid = wgid / nig, fm = gid * WGM, gsz = (nM - fm) < WGM ? (nM - fm) : WGM;
        u.pm = fm + ((wgid % nig) % gsz); u.pn = (wgid % nig) / gsz; return true;
    }
    __device__ __forceinline__ void a_ready(const Unit&) const {}
    __device__ __forceinline__ void done(const Unit&) const {}
};

__device__ __forceinline__ unsigned cvt_pk_bf16(float lo, float hi) { unsigned r; asm volatile("v_cvt_pk_bf16_f32 %0, %1, %2" : "=v"(r) : "v"(lo), "v"(hi)); return r; }
__device__ __forceinline__ int opaque(int x) { asm volatile("" : "+v"(x)); return x; }
__device__ __forceinline__ float sigmoid_f(float v) { return __builtin_amdgcn_rcpf(1.f + __builtin_amdgcn_exp2f(-1.4426950408889634f * v)); }
__device__ __forceinline__ float silu_f(float v) { return v * sigmoid_f(v); }
__device__ __forceinline__ u32x4 pack8(const f32x4& a, const f32x4& b) { u32x4 w; w.x = cvt_pk_bf16(a[0], a[1]); w.y = cvt_pk_bf16(a[2], a[3]); w.z = cvt_pk_bf16(b[0], b[1]); w.w = cvt_pk_bf16(b[2], b[3]); return w; }
__device__ __forceinline__ float sumsq8(const f32x4& a, const f32x4& b) { return ((a[0] * a[0] + a[1] * a[1]) + (a[2] * a[2] + a[3] * a[3])) + ((b[0] * b[0] + b[1] * b[1]) + (b[2] * b[2] + b[3] * b[3])); }
__device__ __forceinline__ void rope8(f32x4& v0, f32x4& v1, const float* cs, const float* sn, size_t grow, int i0) {
    const f32x4 c = *(const f32x4*)(cs + grow * 32 + i0), s = *(const f32x4*)(sn + grow * 32 + i0);
    const f32x4 a = v0, b = v1;
    v0[0] = a[0] * c[0] - a[1] * s[0]; v0[1] = a[1] * c[0] + a[0] * s[0];
    v0[2] = a[2] * c[1] - a[3] * s[1]; v0[3] = a[3] * c[1] + a[2] * s[1];
    v1[0] = b[0] * c[2] - b[1] * s[2]; v1[1] = b[1] * c[2] + b[0] * s[2];
    v1[2] = b[2] * c[3] - b[3] * s[3]; v1[3] = b[3] * c[3] + b[2] * s[3];
}

struct EpiMlaIn {
    static constexpr bool PERM = true, AFTER_DRAIN = false;
    bf16_t* Z; const float* ssqx; float* ssql; const float* cs; const float* sn;
    __device__ __forceinline__ void operator()(const f32x4 (&acc)[2][2][4][2], const Unit& u, int wr, int wc, int fr_, int fq_) const {
        const int lane_ = opaque((int)(threadIdx.x & 63)), fr = lane_ & 15, fq = lane_ >> 4;
        const int pn = u.pn;
#pragma unroll
        for (int ai = 0; ai < 2; ++ai)
#pragma unroll
            for (int m = 0; m < 4; ++m) {
                const size_t grow = (size_t)(u.pm * BM + ai * HALF + wr * 64 + m * 16 + fr);
                const f32x4 sx = *(const f32x4*)(ssqx + grow * 4);
                const float rstd = rsqrtf(((sx[0] + sx[1]) + (sx[2] + sx[3])) * (1.0f / 1024.0f) + RMS_EPS);
                float s = 0.f;
#pragma unroll
                for (int bj = 0; bj < 2; ++bj) {
                    f32x4 v0 = acc[ai][bj][m][0] * rstd, v1 = acc[ai][bj][m][1] * rstd;
                    const int col0 = pn * BM + bj * HALF + wc * 32 + 8 * fq;
                    bf16_t* dst = Z + grow * ZP + col0;
                    if (pn >= 3) {
#pragma unroll
                        for (int j = 0; j < 4; ++j) { v0[j] = silu_f(v0[j]); v1[j] = silu_f(v1[j]); }
                        *(u32x4*)dst = pack8(v0, v1);
                    } else if (pn == 1 && bj == 1) {
                        if (wc < 2) { rope8(v0, v1, cs, sn, grow, 16 * wc + 4 * fq); *(u32x4*)dst = pack8(v0, v1); }
                    } else { s += sumsq8(v0, v1); *(u32x4*)dst = pack8(v0, v1); }
                }
                if (pn <= 2) { s += __shfl_xor(s, 16); s += __shfl_xor(s, 32); if (fq == 0) ssql[grow * 12 + pn * 4 + wc] = s; }
                if (m & 1) asm volatile("" ::: "memory");
            }
    }
};
struct EpiQ {
    static constexpr bool PERM = true, AFTER_DRAIN = false;
    bf16_t* Q; const float* ssql; const float* cs; const float* sn;
    __device__ __forceinline__ void operator()(const f32x4 (&acc)[2][2][4][2], const Unit& u, int wr, int wc, int fr_, int fq_) const {
        const int lane_ = opaque((int)(threadIdx.x & 63)), fr = lane_ & 15, fq = lane_ >> 4;
#pragma unroll
        for (int ai = 0; ai < 2; ++ai)
#pragma unroll
            for (int m = 0; m < 4; ++m) {
                const size_t grow = (size_t)(u.pm * BM + ai * HALF + wr * 64 + m * 16 + fr);
                const f32x4 a = *(const f32x4*)(ssql + grow * 12), b = *(const f32x4*)(ssql + grow * 12 + 4);
                const float rstd = rsqrtf((((a[0] + a[1]) + (a[2] + a[3])) + ((b[0] + b[1]) + (b[2] + b[3]))) * (1.0f / 384.0f) + RMS_EPS);
#pragma unroll
                for (int bj = 0; bj < 2; ++bj) {
                    f32x4 v0 = acc[ai][bj][m][0] * rstd, v1 = acc[ai][bj][m][1] * rstd;
                    const int cw = u.pn * BM + bj * HALF + wc * 32, hd = cw % 192, col0 = cw + 8 * fq;
                    if (hd >= 128) rope8(v0, v1, cs, sn, grow, ((hd - 128) >> 1) + 4 * fq);
                    *(u32x4*)(Q + grow * QP + col0) = pack8(v0, v1);
                }
                asm volatile("" ::: "memory");
            }
    }
};
struct EpiKV {
    static constexpr bool PERM = true, AFTER_DRAIN = false;
    bf16_t* KV; const float* ssql;
    __device__ __forceinline__ void operator()(const f32x4 (&acc)[2][2][4][2], const Unit& u, int wr, int wc, int fr_, int fq_) const {
        const int lane_ = opaque((int)(threadIdx.x & 63)), fr = lane_ & 15, fq = lane_ >> 4;
#pragma unroll
        for (int ai = 0; ai < 2; ++ai)
#pragma unroll
            for (int m = 0; m < 4; ++m) {
                const size_t grow = (size_t)(u.pm * BM + ai * HALF + wr * 64 + m * 16 + fr);
                const f32x4 a = *(const f32x4*)(ssql + grow * 12 + 8);
                const float rstd = rsqrtf(((a[0] + a[1]) + (a[2] + a[3])) * (1.0f / 256.0f) + RMS_EPS);
#pragma unroll
                for (int bj = 0; bj < 2; ++bj) {
                    const f32x4 v0 = acc[ai][bj][m][0] * rstd, v1 = acc[ai][bj][m][1] * rstd;
                    const int col0 = u.pn * BM + bj * HALF + wc * 32 + 8 * fq;
                    *(u32x4*)(KV + grow * KVP + col0) = pack8(v0, v1);
                }
                if (m & 1) asm volatile("" ::: "memory");
            }
    }
};
struct EpiConvIn {
    static constexpr bool PERM = true, AFTER_DRAIN = false;
    bf16_t* U; bf16_t* G; const float* ssqx; const float* bias;
    __device__ __forceinline__ void operator()(const f32x4 (&acc)[2][2][4][2], const Unit& u, int wr, int wc, int fr_, int fq_) const {
        const int lane_ = opaque((int)(threadIdx.x & 63)), fr = lane_ & 15, fq = lane_ >> 4;
        const int pn = u.pn;
#pragma unroll
        for (int ai = 0; ai < 2; ++ai)
#pragma unroll
            for (int m = 0; m < 4; ++m) {
                const size_t grow = (size_t)(u.pm * BM + ai * HALF + wr * 64 + m * 16 + fr);
                const f32x4 sx = *(const f32x4*)(ssqx + grow * 4);
                const float rstd = rsqrtf(((sx[0] + sx[1]) + (sx[2] + sx[3])) * (1.0f / 1024.0f) + RMS_EPS);
#pragma unroll
                for (int bj = 0; bj < 2; ++bj) {
                    f32x4 v0 = acc[ai][bj][m][0] * rstd, v1 = acc[ai][bj][m][1] * rstd;
                    if (pn < 8) {
                        const int c0 = pn * 128 + bj * 64 + wc * 16 + 4 * fq;
                        const f32x4 ba = *(const f32x4*)(bias + c0), bb = *(const f32x4*)(bias + 1024 + c0);
                        const float u0 = (v0[0] + ba[0]) * sigmoid_f(v0[1] + bb[0]), u1 = (v0[2] + ba[1]) * sigmoid_f(v0[3] + bb[1]);
                        const float u2 = (v1[0] + ba[2]) * sigmoid_f(v1[1] + bb[2]), u3 = (v1[2] + ba[3]) * sigmoid_f(v1[3] + bb[3]);
                        u32x2 w; w.x = cvt_pk_bf16(u0, u1); w.y = cvt_pk_bf16(u2, u3);
                        *(u32x2*)(U + grow * 1024 + c0) = w;
                    } else {
                        const int c0 = (pn - 8) * BM + bj * HALF + wc * 32 + 8 * fq;
                        const f32x4 b0 = *(const f32x4*)(bias + 2048 + c0), b1 = *(const f32x4*)(bias + 2048 + c0 + 4);
#pragma unroll
                        for (int j = 0; j < 4; ++j) { v0[j] = silu_f(v0[j] + b0[j]); v1[j] = silu_f(v1[j] + b1[j]); }
                        *(u32x4*)(G + grow * 1024 + c0) = pack8(v0, v1);
                    }
                }
                if (m & 1) asm volatile("" ::: "memory");
            }
    }
};
struct EpiResid {
    static constexpr bool PERM = true, AFTER_DRAIN = true;
    const float* xin; float* xout; bf16_t* xb; float* ssq; const float* bias;
    __device__ __forceinline__ void fused(f32x4 (&acc)[2][2][4][2], const Unit& u, int wr, int wc, int fr_, int fq_, PG8_LAS unsigned char* lds, int wid, int lane) const {
        const int lane_ = opaque(lane), fr = lane_ & 15, fq = lane_ >> 4;
        PG8_LAS float* P = (PG8_LAS float*)lds;
#pragma unroll
        for (int ai = 0; ai < 2; ++ai)
#pragma unroll
            for (int m = 0; m < 4; ++m) {
                const int rt = ai * HALF + wr * 64 + m * 16 + fr;
                const size_t grow = (size_t)(u.pm * BM + rt);
                float s = 0.f;
#pragma unroll
                for (int bj = 0; bj < 2; ++bj) {
                    const int col0 = u.pn * BM + bj * HALF + wc * 32 + 8 * fq;
                    f32x4 v0 = acc[ai][bj][m][0] + *(const f32x4*)(xin + grow * 1024 + col0), v1 = acc[ai][bj][m][1] + *(const f32x4*)(xin + grow * 1024 + col0 + 4);
                    if (bias) { v0 += *(const f32x4*)(bias + col0); v1 += *(const f32x4*)(bias + col0 + 4); }
                    *(f32x4*)(xout + grow * 1024 + col0) = v0; *(f32x4*)(xout + grow * 1024 + col0 + 4) = v1;
                    *(u32x4*)(xb + grow * 1024 + col0) = pack8(v0, v1);
                    s += sumsq8(v0, v1);
                }
                s += __shfl_xor(s, 16); s += __shfl_xor(s, 32);
                if (fq == 0) P[rt * 4 + wc] = s;
                if (m & 1) asm volatile("" ::: "memory");
            }
        asm volatile("s_waitcnt lgkmcnt(0)" ::: "memory"); __builtin_amdgcn_s_barrier(); asm volatile("" ::: "memory");
        const int t = wid * 64 + lane;
        if (t < 256) { const PG8_LAS f32x4* p4 = (const PG8_LAS f32x4*)P; const f32x4 p = p4[t]; ssq[(size_t)(u.pm * BM + t) * 4 + u.pn] = (p[0] + p[1]) + (p[2] + p[3]); }
        asm volatile("s_waitcnt lgkmcnt(0)" ::: "memory"); __builtin_amdgcn_s_barrier(); asm volatile("" ::: "memory");
    }
};

template <class Epi, class Sched, bool ALIGN_EPI = false, bool SP2 = false>
__device__ __forceinline__ void gemm_phase(PG8_LAS unsigned char* lds, const Gemm g, const Sched& S, const Epi& E) {
    const int tid = opaque((int)threadIdx.x), wid = __builtin_amdgcn_readfirstlane(tid >> 6), lane = tid & 63, wr = wid >> 2, wc = wid & 3, fr = lane & 15, fq = lane >> 4;
    const int K = g.K, nt = K / BK, lda = g.lda;
    unsigned voffA[2], voffB[2];
#pragma unroll
    for (int i = 0; i < 2; ++i) { int R, C; stage_rc(tid * 16 + i * 8192, R, C); const int Rb = Epi::PERM ? ((R & ~31) + perm32(R & 31)) : R;
        voffA[i] = (unsigned)(R * lda + C) * 2u; voffB[i] = (unsigned)(Rb * K + C) * 2u; }
    const size_t kstep = (size_t)(BK * 2);
    const size_t hstepA = (size_t)HALF * lda * 2, hstepB = (size_t)HALF * K * 2;
    const size_t tstepA = 2 * hstepA, tstepB = 2 * hstepB;
    const unsigned ldsw = (unsigned)wid * 1024u;
    const int aoff = lds_byte(wr * 64 + fr, fq * 8), boff = lds_byte(wc * 32 + fr, fq * 8);
#define PG8_SA(b, h) (((b) * 2 + (h)) * HTB)
#define PG8_SB(b, h) ((4 + (b) * 2 + (h)) * HTB)
#define PG8_STAGE(bufoff, gbase, voff) do { _Pragma("unroll") for (int _i = 0; _i < 2; ++_i) \
        __builtin_amdgcn_global_load_lds((const unsigned*)((const char*)(gbase) + (voff)[_i]), (PG8_LAS unsigned*)(lds + (bufoff) + ldsw + _i * 8192), 16, 0, 0); } while (0)
#define PG8_LDA(dst, b, h) do { _Pragma("unroll") for (int m = 0; m < 4; ++m) _Pragma("unroll") for (int k = 0; k < 2; ++k) dst[m][k] = *(const PG8_LAS bf16x8*)(lds + PG8_SA(b, h) + aoff + m * 2048 + k * 1024); } while (0)
#define PG8_LDB(dst, b, h) do { _Pragma("unroll") for (int n = 0; n < 2; ++n) _Pragma("unroll") for (int k = 0; k < 2; ++k) dst[n][k] = *(const PG8_LAS bf16x8*)(lds + PG8_SB(b, h) + boff + n * 2048 + k * 1024); } while (0)
#define PG8_MMA(ai, bj, At, Bt) do { __builtin_amdgcn_s_setprio(1); _Pragma("unroll") for (int m = 0; m < 4; ++m) _Pragma("unroll") for (int n = 0; n < 2; ++n) _Pragma("unroll") for (int k = 0; k < 2; ++k) \
        acc[ai][bj][m][n] = __builtin_amdgcn_mfma_f32_16x16x32_bf16(Bt[n][k], At[m][k], acc[ai][bj][m][n], 0, 0, 0); __builtin_amdgcn_s_setprio(0); } while (0)
#define PG8_WAIT_V(n) asm volatile("s_waitcnt vmcnt(" #n ")" ::: "memory")
#define PG8_WAIT_L(n) asm volatile("s_waitcnt lgkmcnt(" #n ")" ::: "memory")
#define PG8_BAR __builtin_amdgcn_s_barrier()
#define PG8_SCHED __builtin_amdgcn_sched_barrier(0)
    Unit cur, nxt; int ui = 0;
    if (!S.next(0, cur)) return;
    f32x4 acc[2][2][4][2];
#pragma unroll
    for (int a = 0; a < 2; ++a)
#pragma unroll
        for (int b = 0; b < 2; ++b)
#pragma unroll
            for (int m = 0; m < 4; ++m)
#pragma unroll
                for (int n = 0; n < 2; ++n) acc[a][b][m][n] = (f32x4){0.f, 0.f, 0.f, 0.f};
    bf16x8 At[4][2], B0[2][2], B1[2][2];
    const char* cA = (const char*)g.A + (size_t)cur.pm * tstepA; const char* cB = (const char*)g.Bt + (size_t)cur.pn * tstepB;
    S.a_ready(cur);
    if constexpr (SP2) {
        PG8_STAGE(PG8_SB(0, 0), cB, voffB); PG8_STAGE(PG8_SB(0, 1), cB + hstepB, voffB); PG8_STAGE(PG8_SA(0, 0), cA, voffA); PG8_STAGE(PG8_SA(0, 1), cA + hstepA, voffA);
        if (wr == 1) PG8_BAR;
        PG8_WAIT_V(2); PG8_BAR;
        PG8_STAGE(PG8_SB(1, 0), cB + kstep, voffB); PG8_STAGE(PG8_SA(1, 0), cA + kstep, voffA); PG8_STAGE(PG8_SB(1, 1), cB + hstepB + kstep, voffB);
        PG8_WAIT_V(6); PG8_BAR;
    } else {
        PG8_STAGE(PG8_SB(0, 0), cB, voffB); PG8_STAGE(PG8_SA(0, 0), cA, voffA); PG8_STAGE(PG8_SB(0, 1), cB + hstepB, voffB); PG8_STAGE(PG8_SA(0, 1), cA + hstepA, voffA);
        if (wr == 1) PG8_BAR;
        PG8_WAIT_V(4); PG8_BAR;
        PG8_STAGE(PG8_SB(1, 0), cB + kstep, voffB); PG8_STAGE(PG8_SA(1, 0), cA + kstep, voffA); PG8_STAGE(PG8_SB(1, 1), cB + hstepB + kstep, voffB);
        PG8_WAIT_V(6); PG8_BAR;
    }
    for (;;) {
        const bool has_next = S.next(ui + 1, nxt);
        const char* nA = has_next ? (const char*)g.A + (size_t)nxt.pm * tstepA : cA; const char* nB = has_next ? (const char*)g.Bt + (size_t)nxt.pn * tstepB : cB;
#pragma nounroll
        for (int t = 0; t < nt; t += 2) {
            const bool last = (t == nt - 2);
            const char* a1 = cA + (size_t)(t + 1) * kstep;
            const char* a2 = last ? nA : cA + (size_t)(t + 2) * kstep; const char* b2 = last ? nB : cB + (size_t)(t + 2) * kstep;
            const char* a3 = a2 + kstep; const char* b3 = b2 + kstep;
            if (last && has_next) S.a_ready(nxt);
            if constexpr (SP2) {
            PG8_LDB(B0, 0, 0); PG8_LDB(B1, 0, 1); PG8_SCHED; PG8_LDA(At, 0, 0); PG8_STAGE(PG8_SA(1, 1), a1 + hstepA, voffA);
            PG8_WAIT_V(8); PG8_WAIT_L(0); PG8_BAR; PG8_MMA(0, 0, At, B0); PG8_MMA(0, 1, At, B1); PG8_BAR; PG8_SCHED;
            PG8_LDA(At, 0, 1); PG8_STAGE(PG8_SB(0, 0), b2, voffB); PG8_STAGE(PG8_SB(0, 1), b2 + hstepB, voffB); PG8_STAGE(PG8_SA(0, 0), a2, voffA);
            PG8_WAIT_V(8); PG8_WAIT_L(0); PG8_BAR; PG8_MMA(1, 0, At, B0); PG8_MMA(1, 1, At, B1); PG8_BAR; PG8_SCHED;
            PG8_LDB(B0, 1, 0); PG8_LDB(B1, 1, 1); PG8_SCHED; PG8_LDA(At, 1, 0); PG8_STAGE(PG8_SA(0, 1), a2 + hstepA, voffA);
            PG8_WAIT_V(8); PG8_WAIT_L(0); PG8_BAR; PG8_MMA(0, 0, At, B0); PG8_MMA(0, 1, At, B1); PG8_BAR; PG8_SCHED;
            PG8_LDA(At, 1, 1); PG8_STAGE(PG8_SB(1, 0), b3, voffB); PG8_STAGE(PG8_SB(1, 1), b3 + hstepB, voffB); PG8_STAGE(PG8_SA(1, 0), a3, voffA);
            PG8_WAIT_V(8); PG8_WAIT_L(0); PG8_BAR; PG8_MMA(1, 0, At, B0); PG8_MMA(1, 1, At, B1); PG8_BAR; PG8_SCHED;
            } else {
            PG8_LDB(B0, 0, 0); PG8_SCHED; PG8_LDA(At, 0, 0); PG8_STAGE(PG8_SA(1, 1), a1 + hstepA, voffA);
            PG8_WAIT_L(8); PG8_BAR; PG8_WAIT_L(0); PG8_MMA(0, 0, At, B0); PG8_BAR; PG8_SCHED;
            PG8_LDB(B1, 0, 1); PG8_STAGE(PG8_SB(0, 0), b2, voffB);
            PG8_BAR; PG8_WAIT_L(0); PG8_MMA(0, 1, At, B1); PG8_BAR;
            PG8_LDA(At, 0, 1); PG8_STAGE(PG8_SA(0, 0), a2, voffA);
            PG8_BAR; PG8_WAIT_L(0); PG8_MMA(1, 0, At, B0); PG8_BAR; PG8_SCHED;
            PG8_STAGE(PG8_SB(0, 1), b2 + hstepB, voffB);
            PG8_WAIT_V(6); PG8_BAR; PG8_MMA(1, 1, At, B1); PG8_BAR;
            PG8_LDB(B0, 1, 0); PG8_SCHED; PG8_LDA(At, 1, 0); PG8_STAGE(PG8_SA(0, 1), a2 + hstepA, voffA);
            PG8_WAIT_L(8); PG8_BAR; PG8_WAIT_L(0); PG8_MMA(0, 0, At, B0); PG8_BAR; PG8_SCHED;
            PG8_LDB(B1, 1, 1); PG8_STAGE(PG8_SB(1, 0), b3, voffB);
            PG8_BAR; PG8_WAIT_L(0); PG8_MMA(0, 1, At, B1); PG8_BAR;
            PG8_LDA(At, 1, 1); PG8_STAGE(PG8_SA(1, 0), a3, voffA);
            PG8_BAR; PG8_WAIT_L(0); PG8_MMA(1, 0, At, B0); PG8_BAR; PG8_SCHED;
            PG8_STAGE(PG8_SB(1, 1), b3 + hstepB, voffB);
            PG8_WAIT_V(6); PG8_BAR; PG8_MMA(1, 1, At, B1); PG8_BAR;
            }
        }
        if constexpr (ALIGN_EPI) { if (wr == 0) PG8_BAR; }
        if constexpr (!Epi::AFTER_DRAIN) { E(acc, cur, wr, wc, fr, fq); S.done(cur); }
        if (!has_next) break;
#pragma unroll
        for (int a = 0; a < 2; ++a)
#pragma unroll
            for (int b = 0; b < 2; ++b)
#pragma unroll
                for (int m = 0; m < 4; ++m)
#pragma unroll
                    for (int n = 0; n < 2; ++n) acc[a][b][m][n] = (f32x4){0.f, 0.f, 0.f, 0.f};
        cur = nxt; cA = nA; cB = nB; ++ui;
        if constexpr (ALIGN_EPI) { if (wr == 1) PG8_BAR; }
    }
    PG8_WAIT_V(0);
    if constexpr (!ALIGN_EPI) { if (wr == 0) PG8_BAR; }
    PG8_BAR;
    if constexpr (Epi::AFTER_DRAIN) { E.fused(acc, cur, wr, wc, fr, fq, lds, wid, lane); S.done(cur); }
#undef PG8_SA
#undef PG8_SB
#undef PG8_STAGE
#undef PG8_LDA
#undef PG8_LDB
#undef PG8_MMA
#undef PG8_WAIT_V
#undef PG8_WAIT_L
#undef PG8_BAR
#undef PG8_SCHED
}
}

namespace attn {
using bf16 = __hip_bfloat16;
typedef short bf16x8 __attribute__((ext_vector_type(8)));
typedef short s16x4 __attribute__((ext_vector_type(4)));
typedef float f32x16 __attribute__((ext_vector_type(16)));
typedef float f32x4 __attribute__((ext_vector_type(4)));
typedef unsigned u32x4 __attribute__((ext_vector_type(4)));
constexpr int D = 128, DQK = 192;
constexpr float THR = 8.f;
constexpr float SCALE = 0.07216878364870322f;
constexpr int NW = 8, QBLK = 32, KVBLK = 64, QB = NW * QBLK;
constexpr int SHM_V = KVBLK * D * 2, SHM_K = KVBLK * D * 2, SHM_KP = KVBLK * 64 * 2;
constexpr int OFF_K = 2 * SHM_V, OFF_KP = OFF_K + 2 * SHM_K, OFF_WS = OFF_KP + 2 * SHM_KP, OFF_OST = OFF_WS + NW * 64 * 4, LDS_BYTES = OFF_OST + NW * 8192;
constexpr int NQD = DQK / 16;

#define KSWZ(row, colB) ((row) * 256 + ((colB) ^ (((row) & 7) << 4)))
#define SBAR() __builtin_amdgcn_sched_barrier(0)
__device__ __forceinline__ int v_st(int k, int c) { const int kk = (k & ~0xC) | ((k & 4) << 1) | ((k & 8) >> 1); return ((kk >> 3) * 4 + (c >> 5)) * 512 + ((kk & 7) * 32 + (c & 31)) * 2; }
__device__ __forceinline__ int v_rd_base(int lane) { return ((lane & 3) << 3) | (((lane >> 2) & 3) << 6) | (((lane >> 4) & 1) << 5) | (((lane >> 5) & 1) << 8); }
constexpr int v_rd_off(int d0, int ks, int half) { return d0 * 512 + ks * 4096 + half * 2048; }
__device__ __forceinline__ int crow(int r, int hi) { return (r & 3) + 8 * (r >> 2) + 4 * hi; }
__device__ __forceinline__ unsigned cvtpk(float lo, float hi) { unsigned r; asm volatile("v_cvt_pk_bf16_f32 %0, %1, %2" : "=v"(r) : "v"(lo), "v"(hi)); return r; }
__device__ __forceinline__ int opaque(int x) { asm volatile("" : "+v"(x)); return x; }
__device__ __forceinline__ bf16x8 load8(const bf16* p) { return *reinterpret_cast<const bf16x8*>(p); }
__device__ __forceinline__ void mask_tile(f32x16& p0, f32x16& p1, int dq) {
    const float NEG = -__builtin_inff();
#pragma unroll
    for (int r = 0; r < 16; ++r) {
        const int c = (r & 3) + 8 * (r >> 2);
        if (dq - c < 0) p0[r] = NEG;
        if (dq - c - 32 < 0) p1[r] = NEG;
    }
}
__device__ __forceinline__ void partialSM(f32x16& p0, f32x16& p1, float& m_reg, float& mn, float& alpha) {
    float pmax = p0[0];
#pragma unroll
    for (int r = 1; r < 16; ++r) pmax = fmaxf(pmax, p0[r]);
#pragma unroll
    for (int r = 0; r < 16; ++r) pmax = fmaxf(pmax, p1[r]);
    { auto rr = __builtin_amdgcn_permlane32_swap(__float_as_uint(pmax), __float_as_uint(pmax), false, false);
      pmax = fmaxf(__uint_as_float(rr[0]), __uint_as_float(rr[1])); }
    constexpr float C2 = 1.4426950408889634f * SCALE;
    if (__builtin_expect(__all((pmax - m_reg) * SCALE <= THR), 1)) { mn = m_reg; alpha = 1.f; }
    else { mn = fmaxf(m_reg, pmax); alpha = __builtin_amdgcn_exp2f((m_reg - mn) * C2); m_reg = mn; }
    const float mnL = -mn * C2;
#pragma unroll
    for (int r = 0; r < 16; ++r) p0[r] = fmaf(p0[r], C2, mnL);
#pragma unroll
    for (int r = 0; r < 16; ++r) p1[r] = fmaf(p1[r], C2, mnL);
#pragma unroll
    for (int r = 0; r < 16; ++r) p0[r] = __builtin_amdgcn_exp2f(p0[r]);
}
__device__ __forceinline__ void finishSM(f32x16& p0, f32x16& p1, float alpha, float& l_reg, bf16x8& pa0, bf16x8& pa1, bf16x8& pa2, bf16x8& pa3) {
#pragma unroll
    for (int r = 0; r < 16; ++r) p1[r] = __builtin_amdgcn_exp2f(p1[r]);
    float ps = 0;
#pragma unroll
    for (int r = 0; r < 16; ++r) ps += p0[r];
#pragma unroll
    for (int r = 0; r < 16; ++r) ps += p1[r];
    { auto rr = __builtin_amdgcn_permlane32_swap(__float_as_uint(ps), __float_as_uint(ps), false, false);
      ps = __uint_as_float(rr[0]) + __uint_as_float(rr[1]); }
    l_reg = l_reg * alpha + ps;
#define PK4(P, B_, OUT) do { unsigned a0 = cvtpk(P[B_+0], P[B_+1]), a1 = cvtpk(P[B_+2], P[B_+3]);                          \
        unsigned b0 = cvtpk(P[B_+4], P[B_+5]), b1 = cvtpk(P[B_+6], P[B_+7]);                                             \
        auto r0 = __builtin_amdgcn_permlane32_swap(a0, b0, false, false); auto r1 = __builtin_amdgcn_permlane32_swap(a1, b1, false, false); \
        u32x4 w = {r0[0], r1[0], r0[1], r1[1]}; OUT = *reinterpret_cast<bf16x8*>(&w); } while (0)
    PK4(p0, 0, pa0); PK4(p0, 8, pa1); PK4(p1, 0, pa2); PK4(p1, 8, pa3);
#undef PK4
}
template <int KB>
__device__ __forceinline__ void qkt(f32x16& p0, f32x16& p1, const char* K_lds, int r32, int hi, const bf16x8* qr, const char* qpl) {
    p0 = f32x16{}; p1 = f32x16{};
    const char* kb[4];
#pragma unroll
    for (int dd = 0; dd < 4; ++dd) kb[dd] = K_lds + KB * SHM_K + KSWZ(r32, (dd * 16 + hi * 8) * 2);
#pragma unroll
    for (int d0 = 0; d0 < 8; ++d0) { const char* a = kb[d0 & 3] + (d0 >> 2) * 128;
        bf16x8 b0 = *reinterpret_cast<const bf16x8*>(a);
        bf16x8 b1 = *reinterpret_cast<const bf16x8*>(a + 32 * 256);
        p0 = __builtin_amdgcn_mfma_f32_32x32x16_bf16(b0, qr[d0], p0, 0, 0, 0);
        p1 = __builtin_amdgcn_mfma_f32_32x32x16_bf16(b1, qr[d0], p1, 0, 0, 0); }
#pragma unroll
    for (int e = 0; e < 4; ++e) { const char* a = kb[e] + (2 * SHM_K - KB * SHM_K + KB * SHM_KP);
        bf16x8 b0 = *reinterpret_cast<const bf16x8*>(a);
        bf16x8 b1 = *reinterpret_cast<const bf16x8*>(a + 128);
        const bf16x8 qe = *reinterpret_cast<const bf16x8*>(qpl + e * 1024);
        p0 = __builtin_amdgcn_mfma_f32_32x32x16_bf16(b0, qe, p0, 0, 0, 0);
        p1 = __builtin_amdgcn_mfma_f32_32x32x16_bf16(b1, qe, p1, 0, 0, 0); }
}
template <int VB>
__device__ __forceinline__ void pv_tile(f32x16* o, int vb0, bf16x8 pa0, bf16x8 pa1, bf16x8 pa2, bf16x8 pa3) {
#define TRRD(dst, off) asm volatile("ds_read_b64_tr_b16 %0, %1 offset:%2" : "=&v"(dst) : "v"(vb0), "i"(off) : "memory")
#define PV_D0(d0) do { s16x4 l0, l1, l2, l3, h0, h1, h2, h3; constexpr int b_ = VB * SHM_V + v_rd_off(d0, 0, 0);     \
        TRRD(l0, b_); TRRD(h0, b_ + 2048); TRRD(l1, b_ + 4096); TRRD(h1, b_ + 6144); TRRD(l2, b_ + 8192); TRRD(h2, b_ + 10240); TRRD(l3, b_ + 12288); TRRD(h3, b_ + 14336); \
        asm volatile("s_waitcnt lgkmcnt(0)" ::: "memory"); SBAR();                                                                  \
        o[d0] = __builtin_amdgcn_mfma_f32_32x32x16_bf16(pa0, (bf16x8){l0[0], l0[1], l0[2], l0[3], h0[0], h0[1], h0[2], h0[3]}, o[d0], 0, 0, 0);   \
        o[d0] = __builtin_amdgcn_mfma_f32_32x32x16_bf16(pa1, (bf16x8){l1[0], l1[1], l1[2], l1[3], h1[0], h1[1], h1[2], h1[3]}, o[d0], 0, 0, 0);   \
        o[d0] = __builtin_amdgcn_mfma_f32_32x32x16_bf16(pa2, (bf16x8){l2[0], l2[1], l2[2], l2[3], h2[0], h2[1], h2[2], h2[3]}, o[d0], 0, 0, 0);   \
        o[d0] = __builtin_amdgcn_mfma_f32_32x32x16_bf16(pa3, (bf16x8){l3[0], l3[1], l3[2], l3[3], h3[0], h3[1], h3[2], h3[3]}, o[d0], 0, 0, 0); } while (0)
    PV_D0(0); PV_D0(1); PV_D0(2); PV_D0(3);
#undef PV_D0
#undef TRRD
}

typedef __amdgpu_buffer_rsrc_t rsrc_t;
struct BlockRef { unsigned q, kn, kp, o, g; int P0; };
struct Seam { bf16x8 qr[8]; bf16x8 qpe[4]; bf16x8 st_v0, st_v1, st_k0, st_k1, st_kp; };
__device__ __forceinline__ bf16x8 bld8(rsrc_t r, unsigned voff, unsigned soff) { const u32x4 v = __builtin_amdgcn_raw_buffer_load_b128(r, voff, soff, 0); return __builtin_bit_cast(bf16x8, v); }
#define VMW() asm volatile("s_waitcnt vmcnt(0)" ::: "memory")
#define VMWN(n) asm volatile("s_waitcnt vmcnt(%0)" :: "i"(n) : "memory")
#define SLOAD(R, k0) do { const unsigned so_ = (R).kn + (unsigned)(k0) * (KVP * 2), sp_ = (R).kp + (unsigned)(k0) * (ZP * 2);                       \
                          S.st_v0 = bld8(rs, vkv + 256, so_); S.st_v1 = bld8(rs, vkv + 256, so_ + 32 * KVP * 2);                                   \
                          S.st_k0 = bld8(rs, vkv, so_); S.st_k1 = bld8(rs, vkv, so_ + 32 * KVP * 2);                                               \
                          S.st_kp = bld8(rs, vkp, sp_); } while (0)
#define QLOAD(R) do { _Pragma("unroll") for (int d0 = 0; d0 < 8; ++d0) S.qr[d0] = bld8(rs, vq + d0 * 32, (R).q); } while (0)
#define QPLOAD(R) do { _Pragma("unroll") for (int e = 0; e < 4; ++e) S.qpe[e] = bld8(rs, vq + (8 + e) * 32, (R).q); } while (0)
#define QPWRITE() do { _Pragma("unroll") for (int e = 0; e < 4; ++e) *(bf16x8*)(qpl + e * 1024) = S.qpe[e]; } while (0)
#define SWRITE_K(bf) do { *(bf16x8*)(K_lds + (bf) * SHM_K + kws) = S.st_k0; *(bf16x8*)(K_lds + (bf) * SHM_K + kws + 32 * 256) = S.st_k1; \
                          *(bf16x8*)(KP_lds + (bf) * SHM_KP + kpw) = S.st_kp; } while (0)
#define SWRITE_V(bf) do { *(bf16x8*)(V_lds + (bf) * SHM_V + vst0) = S.st_v0; *(bf16x8*)(V_lds + (bf) * SHM_V + vst1) = S.st_v1; } while (0)
#define SWRITE_ALL(bf) do { SWRITE_V(bf); SWRITE_K(bf); } while (0)
__device__ __forceinline__ void attn_prime(const BlockRef& cur, rsrc_t rs, char* lds, Seam& S) {
    const int tid = opaque(threadIdx.x), wid = __builtin_amdgcn_readfirstlane(tid >> 6), lane = tid & 63, r32 = lane & 31, hi = lane >> 5;
    const int sr = tid >> 4, sc = (tid & 15) * 8, kws = KSWZ(sr, sc * 2), pr = tid >> 3, pc = tid & 7, kpw = KSWZ(pr & 31, ((pr >> 5) * 8 + pc) * 16);
    const unsigned vq = (unsigned)((wid * QBLK + r32) * QP + hi * 8) * 2u, vkv = (unsigned)(sr * KVP + sc) * 2u, vkp = (unsigned)(pr * ZP + pc * 8) * 2u;
    char* K_lds = lds + OFF_K; char* KP_lds = lds + OFF_KP;
    char* qpl = lds + OFF_OST + wid * 8192 + lane * 16;
    QLOAD(cur); QPLOAD(cur);
    SLOAD(cur, 0); VMW(); SWRITE_K(0); QPWRITE();
    __syncthreads();
}
__device__ __forceinline__ void attn_block(const BlockRef& cur, const BlockRef& nxt, rsrc_t rs, char* lds, Seam& S) {
    const int tid = opaque(threadIdx.x), wid = __builtin_amdgcn_readfirstlane(tid >> 6), lane = tid & 63, r32 = lane & 31, hi = lane >> 5;
    const int NT = (cur.P0 + QB) / KVBLK;
    const int qlo = cur.P0 + wid * QBLK, qm = qlo + r32 - 4 * hi;
    char* V_lds = lds; char* K_lds = lds + OFF_K; char* KP_lds = lds + OFF_KP;
    float* ws = (float*)(lds + OFF_WS) + wid * 64; float* li_l = ws, * al_l = ws + 32;
    float m_reg = -1e30f, l_reg = 0; f32x16 o[4] = {};
    const int sr = tid >> 4, sc = (tid & 15) * 8, vst0 = v_st(sr, sc), vst1 = v_st(32 + sr, sc), kws = KSWZ(sr, sc * 2);
    const int pr = tid >> 3, pc = tid & 7, kpw = KSWZ(pr & 31, ((pr >> 5) * 8 + pc) * 16);
    const int vb0 = (int)(uintptr_t)V_lds + v_rd_base(lane);
    char* qpl = lds + OFF_OST + wid * 8192 + lane * 16;
    const unsigned vkv = (unsigned)(sr * KVP + sc) * 2u, vkp = (unsigned)(pr * ZP + pc * 8) * 2u;
#define RESC(a) do { if (__any((a) < 1.f)) { if (hi == 0) al_l[r32] = (a); asm volatile("s_waitcnt lgkmcnt(0)" ::: "memory");              \
                     for (int d_ = 0; d_ < 4; ++d_) for (int r = 0; r < 16; ++r) o[d_][r] *= al_l[crow(r, hi)]; } } while (0)
#define KBASE(t) ((t) * KVBLK)
#define MASKT(P0_, P1_, t) do { const int kb_ = KBASE(t); if (kb_ + KVBLK - 1 > qlo) mask_tile(P0_, P1_, qm - kb_); } while (0)
    f32x16 pA0, pA1, pB0, pB1; float mnA, mnB, alA, alB; bf16x8 pa0, pa1, pa2, pa3;
    SWRITE_V(0); SBAR();
    if (NT > 1) { SLOAD(cur, KBASE(1)); }
    SBAR(); qkt<0>(pA0, pA1, K_lds, r32, hi, S.qr, qpl);
    MASKT(pA0, pA1, 0); partialSM(pA0, pA1, m_reg, mnA, alA);
    if (NT > 1) { VMW(); SWRITE_ALL(1); }
    __syncthreads();
#define HALF_STEP(PX0, PX1, mnX, alX, PY0, PY1, alY, t, KB, VB, SB) do {                                                      \
        SBAR(); qkt<KB>(PX0, PX1, K_lds, r32, hi, S.qr, qpl);                                                                      \
        finishSM(PY0, PY1, alY, l_reg, pa0, pa1, pa2, pa3); SBAR();                                                           \
        if ((t) + 1 < NT) { SLOAD(cur, KBASE((t) + 1)); SBAR(); }                                                             \
        pv_tile<VB>(o, vb0, pa0, pa1, pa2, pa3); MASKT(PX0, PX1, (t)); partialSM(PX0, PX1, m_reg, mnX, alX);                  \
        __syncthreads();                                                                                                      \
        if ((t) + 1 < NT) { VMW(); SWRITE_ALL(SB); }                                                                          \
        RESC(alX); __syncthreads(); } while (0)
    for (int t = 1; t + 1 < NT; t += 2) {
        HALF_STEP(pB0, pB1, mnB, alB, pA0, pA1, alA, t, 1, 0, 0);
        HALF_STEP(pA0, pA1, mnA, alA, pB0, pB1, alB, t + 1, 0, 1, 1);
    }
    SBAR(); qkt<1>(pB0, pB1, K_lds, r32, hi, S.qr, qpl); SBAR();
    finishSM(pA0, pA1, alA, l_reg, pa0, pa1, pa2, pa3); SBAR();
    pv_tile<0>(o, vb0, pa0, pa1, pa2, pa3);
    SBAR(); { const int l2 = opaque(lane); const unsigned vq = (unsigned)((wid * QBLK + (l2 & 31)) * QP + (l2 >> 5) * 8) * 2u; QLOAD(nxt); } SLOAD(nxt, 0); SBAR();
    MASKT(pB0, pB1, NT - 1); partialSM(pB0, pB1, m_reg, mnB, alB); __syncthreads(); RESC(alB);
    finishSM(pB0, pB1, alB, l_reg, pa0, pa1, pa2, pa3); SBAR(); pv_tile<1>(o, vb0, pa0, pa1, pa2, pa3);
    SBAR(); { const int l2 = opaque(lane); const unsigned vq = (unsigned)((wid * QBLK + (l2 & 31)) * QP + (l2 >> 5) * 8) * 2u; QPLOAD(nxt); }
    SBAR(); VMWN(4); SWRITE_K(0); SBAR();
    if (hi == 0) li_l[r32] = l_reg; asm volatile("s_waitcnt lgkmcnt(0)" ::: "memory");
    float rli[16];
#pragma unroll
    for (int r = 0; r < 16; ++r) rli[r] = __builtin_amdgcn_rcpf(li_l[crow(r, hi)]);
    bf16* stg = (bf16*)(lds + OFF_OST) + wid * 4096;
#pragma unroll
    for (int r = 0; r < 16; ++r) { const int orow = crow(r, hi);
#pragma unroll
        for (int d0 = 0; d0 < 4; ++d0) stg[orow * 128 + d0 * 32 + r32] = __float2bfloat16(o[d0][r] * rli[r]); }
    asm volatile("s_waitcnt lgkmcnt(0)" ::: "memory");
    { const int l3 = opaque(lane); const unsigned vg = (unsigned)((wid * QBLK + (l3 >> 4)) * ZP + (l3 & 15) * 8) * 2u, vo = (unsigned)((wid * QBLK + (l3 >> 4)) * 1024 + (l3 & 15) * 8) * 2u;
#pragma unroll
    for (int i = 0; i < 8; ++i) { const int row = i * 4 + (l3 >> 4), ch = l3 & 15;
        const u32x4 ov = *(const u32x4*)(stg + row * 128 + ch * 8);
        const u32x4 gv = __builtin_amdgcn_raw_buffer_load_b128(rs, vg, cur.g + (unsigned)(i * 4 * ZP * 2), 0);
        u32x4 w;
#pragma unroll
        for (int j = 0; j < 4; ++j) { const float olo = __uint_as_float(ov[j] << 16), ohi = __uint_as_float(ov[j] & 0xffff0000u), glo = __uint_as_float(gv[j] << 16), ghi = __uint_as_float(gv[j] & 0xffff0000u);
            w[j] = cvtpk(olo * glo, ohi * ghi); }
        __builtin_amdgcn_raw_buffer_store_b128(w, rs, vo, cur.o + (unsigned)(i * 4 * 1024 * 2), 0); } }
    asm volatile("s_waitcnt lgkmcnt(0)" ::: "memory"); QPWRITE();
    __syncthreads();
#undef RESC
#undef KBASE
#undef MASKT
#undef HALF_STEP
}
#undef VMW
#undef VMWN
#undef SLOAD
#undef QLOAD
#undef QPLOAD
#undef QPWRITE
#undef SWRITE_K
#undef SWRITE_V
#undef SWRITE_ALL
#undef KSWZ
#undef SBAR
}

constexpr int NWAVES = 8;
constexpr int NSTEPS = 16;
constexpr size_t MiB = 1u << 20;
constexpr size_t WS_CTL = 0, CTL_ZERO_BYTES = 64 * 1024;
constexpr size_t WS_SSQ = 1 * MiB, WS_SSQL = 1 * MiB + 256 * 1024;
constexpr size_t WS_W = 2 * MiB;
constexpr size_t SZ_WINM = (size_t)ZP * 1024 * 2, SZ_WQB = (size_t)QP * Q_LORA * 2, SZ_WKVB = (size_t)KVP * KV_LORA * 2, SZ_WO = (size_t)1024 * 1024 * 2, SZ_WINC = (size_t)CONV_IN * 1024 * 2;
constexpr size_t WS_WINM = WS_W, WS_WQB = WS_WINM + 2 * SZ_WINM, WS_WKVB = WS_WQB + 2 * SZ_WQB, WS_WOM = WS_WKVB + 2 * SZ_WKVB, WS_WINC = WS_WOM + 2 * SZ_WO, WS_WOC = WS_WINC + 2 * SZ_WINC;
static_assert(WS_WOC + 2 * SZ_WO <= 34 * MiB, "weights region");
constexpr size_t WS_COS = 34 * MiB, WS_SIN = 36 * MiB;
constexpr size_t WS_OA = 38 * MiB;
constexpr size_t WS_ZM = 70 * MiB, WS_U = 70 * MiB;
constexpr size_t WS_Q = 126 * MiB, WS_XB = 126 * MiB;
constexpr size_t WS_KV = 174 * MiB, WS_G = 174 * MiB;
constexpr size_t WS_END = 238 * MiB;
constexpr int CW_BAR = 1024;
constexpr int RING_OFF = 0, MISC_OFF = 149504, LDS_BYTES = 150 * 1024;
static_assert(attn::LDS_BYTES <= MISC_OFF && pg8::STAGE_BYTES <= MISC_OFF, "LDS map");

#define GAS __attribute__((address_space(1)))
#define LAS __attribute__((address_space(3)))
typedef unsigned short bf16u;
typedef unsigned v4u __attribute__((ext_vector_type(4)));
typedef float f32x4 __attribute__((ext_vector_type(4)));
typedef float f32x2 __attribute__((ext_vector_type(2)));
typedef GAS unsigned gu32;
#define RLX_AGENT __ATOMIC_RELAXED, __HIP_MEMORY_SCOPE_AGENT
#define LDS_WAIT() asm volatile("s_waitcnt lgkmcnt(0)" ::: "memory")
__device__ __forceinline__ unsigned f2bf(float f) { unsigned u = __builtin_bit_cast(unsigned, f); return (u + 0x7fffu + ((u >> 16) & 1u)) >> 16; }
__device__ __forceinline__ unsigned pk2(float lo, float hi) { return f2bf(lo) | (f2bf(hi) << 16); }

#define XB_TMO      128
#define XB_XCNT(j)  (256  + 64 * (j))
#define XB_XSUB(j)  (1280 + 64 * (j))
#define XB_XGEN(j)  (2304 + 64 * (j))
#define XB_TOP      3328
#define XB_TOPGEN   3392
#define XCD_BAR_WORDS 3456
#define XB_SPIN_CAP (1u << 18)
__device__ __forceinline__ unsigned xb_ld(unsigned* p)              { return __hip_atomic_load(p, __ATOMIC_RELAXED, __HIP_MEMORY_SCOPE_AGENT); }
__device__ __forceinline__ unsigned xb_add(unsigned* p, unsigned v) { return __hip_atomic_fetch_add(p, v, __ATOMIC_RELAXED, __HIP_MEMORY_SCOPE_AGENT); }
__device__ __forceinline__ unsigned xb_xcc_id() { return (unsigned)__builtin_amdgcn_s_getreg((3 << 11) | 20) & 0xFu; }
#define XB_SPIN(cond, bar) do { unsigned _sp = 0; while (cond) { __builtin_amdgcn_s_sleep(1); \
    if ((++_sp & 255u) == 0u) { if (xb_ld(&(bar)[XB_TMO])) break; if (_sp > XB_SPIN_CAP) { atomicAdd(&(bar)[XB_TMO], 1u); break; } } } } while (0)
struct XcdBarrier { unsigned* bar; unsigned x; volatile LAS unsigned* st; };
__device__ __forceinline__ XcdBarrier xcd_barrier_post(unsigned* bar, volatile LAS unsigned* st) {
    XcdBarrier b; b.bar = bar; b.x = xb_xcc_id(); b.st = st;
    if (threadIdx.x == 0) (void)xb_add(&bar[XB_XCNT(b.x)], 1u);
    return b;
}
__device__ __forceinline__ void xcd_barrier_complete(unsigned* bar, unsigned x, unsigned& nloc, unsigned& nx) {
    const unsigned G = gridDim.x * gridDim.y * gridDim.z;
    unsigned sum, cnt, mine, sp = 0u;
    for (;;) {
        sum = 0u; cnt = 0u; mine = 0u;
#pragma unroll
        for (unsigned j = 0; j < 16; ++j) { const unsigned c = xb_ld(&bar[XB_XCNT(j)]); sum += c; cnt += (c > 0u) ? 1u : 0u; mine = (j == x) ? c : mine; }
        if (sum == G) break;
        __builtin_amdgcn_s_sleep(1);
        if ((++sp & 255u) == 0u) { if (xb_ld(&bar[XB_TMO])) break; if (sp > XB_SPIN_CAP) { atomicAdd(&bar[XB_TMO], 1u); break; } }
    }
    nloc = mine > 0u ? mine : 1u; nx = cnt > 0u ? cnt : 1u;
}
__device__ __forceinline__ void xcd_barrier(const XcdBarrier& b) {
    asm volatile("s_waitcnt vmcnt(0)" ::: "memory");
    __syncthreads();
    if (threadIdx.x == 0) {
        unsigned* bar = b.bar;
        __builtin_amdgcn_s_waitcnt(0);
        unsigned nloc = b.st[0], nx = b.st[1];
        if (nloc == 0u) { xcd_barrier_complete(bar, b.x, nloc, nx); b.st[0] = nloc; b.st[1] = nx; }
        const unsigned old = xb_add(&bar[XB_XSUB(b.x)], 1u);
        const unsigned gen = old / nloc;
        if (old + 1u == (gen + 1u) * nloc) {
            __builtin_amdgcn_fence(__ATOMIC_RELEASE, "agent");
            asm volatile("s_waitcnt vmcnt(0)" ::: "memory");
            const unsigned og = xb_add(&bar[XB_TOP], 1u);
            const unsigned tg = og / nx;
            if (og + 1u == (tg + 1u) * nx) xb_add(&bar[XB_TOPGEN], 1u);
            else XB_SPIN(xb_ld(&bar[XB_TOPGEN]) == tg, bar);
            __builtin_amdgcn_fence(__ATOMIC_ACQUIRE, "agent");
            xb_add(&bar[XB_XGEN(b.x)], 1u);
            asm volatile("s_waitcnt vmcnt(0)" ::: "memory");
        } else {
            XB_SPIN(xb_ld(&bar[XB_XGEN(b.x)]) == gen, bar);
            __builtin_amdgcn_fence(__ATOMIC_ACQUIRE, "agent");
            asm volatile("s_waitcnt vmcnt(0)" ::: "memory");
        }
    }
    __syncthreads();
}

__device__ __forceinline__ float wave_sum(float v) {
#pragma unroll
    for (int o = 1; o < 64; o <<= 1) v += __shfl_xor(v, o);
    return v;
}

template <int MAP> __device__ __forceinline__ int dst_row(int n) {
    if (MAP == 1) {
        if (n < 384) return n;
        if (n < 640) return Z_KV + (n - 384);
        if (n < 704) { const int j = n - 640; return Z_KPE + (j < 32 ? 2 * j : 2 * (j - 32) + 1); }
        return Z_GATE + (n - 704);
    }
    if (MAP == 2) {
        const int h = n / 192, d = n % 192; if (d < 128) return n; const int j = d - 128; return h * 192 + 128 + (j < 32 ? 2 * j : 2 * (j - 32) + 1);
    }
    if (MAP == 3) {
        if (n < 2048) { const int c = n & 1023, isb = n >> 10; return 256 * (c >> 7) + 2 * (c & 127) + isb; }
        return n;
    }
    return n;
}
template <int MAP>
__device__ __forceinline__ void p0_transpose_item(const float* W, int K, int N, bf16u* WT, const float* gain, LAS float* scr, int item, int lane) {
    const int nblk = N / 32, kb = item / nblk, nb = item % nblk, k0 = 64 * kb, n0 = 32 * nb;
#pragma unroll 8
    for (int i = 0; i < 32; ++i) { const int kk = 2 * i + (lane >> 5); const float gk = gain ? gain[k0 + kk] : 1.f; scr[kk * 33 + (lane & 31)] = W[(size_t)(k0 + kk) * N + n0 + (lane & 31)] * gk; }
    LDS_WAIT(); asm volatile("" ::: "memory");
    const int c = lane & 7;
#pragma unroll
    for (int j = 0; j < 4; ++j) { const int n = (lane >> 3) + 8 * j; const LAS float* s = scr + (8 * c) * 33 + n;
        v4u o; o.x = pk2(s[0 * 33], s[1 * 33]); o.y = pk2(s[2 * 33], s[3 * 33]); o.z = pk2(s[4 * 33], s[5 * 33]); o.w = pk2(s[6 * 33], s[7 * 33]);
        *(GAS v4u*)(WT + (size_t)dst_row<MAP>(n0 + n) * K + k0 + 8 * c) = o; }
    LDS_WAIT(); asm volatile("" ::: "memory");
}

__constant__ float c_inv_freq[32] = {
    1.0f, 0.7498942093324559f, 0.5623413251903491f, 0.4216965034285822f, 0.31622776601683794f, 0.23713737056616552f, 0.1778279410038923f, 0.1333521432163324f,
    0.1f, 0.07498942093324558f, 0.05623413251903491f, 0.04216965034285822f, 0.03162277660168379f, 0.023713737056616554f, 0.01778279410038923f, 0.01333521432163324f,
    0.01f, 0.007498942093324558f, 0.005623413251903491f, 0.004216965034285823f, 0.0031622776601683794f, 0.0023713737056616554f, 0.0017782794100389228f, 0.001333521432163324f,
    0.001f, 0.0007498942093324559f, 0.0005623413251903491f, 0.00042169650342858224f, 0.00031622776601683794f, 0.00023713737056616554f, 0.00017782794100389227f, 0.0001333521432163324f };


struct Args { const void* in[19]; float* out; unsigned char* ws; int lo, hi; };
typedef __amdgpu_buffer_rsrc_t rsrc_t;

__device__ __forceinline__ void conv_tile(int tile, rsrc_t rs, const float* dw_w, const float* dw_b, const float* ln_g, const float* ln_b, LAS unsigned char* lds) {
    const int tid = pg8::opaque((int)threadIdx.x), lane = tid & 63, wid = __builtin_amdgcn_readfirstlane(tid >> 6);
    const int b = tile >> 6, t0 = (tile & 63) * 32, c = 2 * tid;
    const unsigned rowbase = (unsigned)b * SEQ, vo = (unsigned)tid * 4u;
    const rsrc_t rw = __builtin_amdgcn_make_buffer_rsrc((void*)dw_w, 0, CONV_K * 1024 * 4, 0x00020000);
    float w0[CONV_K], w1[CONV_K];
#pragma unroll
    for (int k = 0; k < CONV_K; ++k) { const f32x2 w = __builtin_bit_cast(f32x2, __builtin_amdgcn_raw_buffer_load_b64(rw, vo * 2u, (unsigned)(k * 4096), 0)); w0[k] = w.x; w1[k] = w.y; }
    float a0[32], a1[32];
#pragma unroll
    for (int t = 0; t < 32; ++t) { a0[t] = 0.f; a1[t] = 0.f; }
#define CONV_LD(r_) ({ const int tt_ = t0 - 30 + (r_); const unsigned uv_ = __builtin_amdgcn_raw_buffer_load_b32(rs, vo, (unsigned)__builtin_amdgcn_readfirstlane((int)((unsigned)WS_U + (rowbase + (unsigned)(tt_ < 0 ? 0 : tt_)) * 2048u)), 0); (tt_ < 0) ? 0u : uv_; })
    unsigned ucur[8], unxt[8];
#pragma unroll
    for (int i = 0; i < 8; ++i) ucur[i] = CONV_LD(i);
#pragma unroll
    for (int g = 0; g < 8; ++g) {
#pragma unroll
        for (int i = 0; i < 8; ++i) { const int r = (g + 1) * 8 + i; unxt[i] = (r < 62) ? CONV_LD(r) : 0u; }
        asm volatile("" ::: "memory"); __builtin_amdgcn_sched_barrier(0);
#pragma unroll
        for (int i = 0; i < 8; ++i) { const int r = g * 8 + i;
            if (r < 62) { const float u0 = __uint_as_float(ucur[i] << 16), u1 = __uint_as_float(ucur[i] & 0xffff0000u);
#pragma unroll
                for (int t = 0; t < 32; ++t) { const int k = r - t; if (k >= 0 && k < CONV_K) { a0[t] = fmaf(w0[k], u0, a0[t]); a1[t] = fmaf(w1[k], u1, a1[t]); } } } }
#pragma unroll
        for (int i = 0; i < 8; ++i) ucur[i] = unxt[i];
    }
#undef CONV_LD
    const f32x2 db = *(const f32x2*)(dw_b + c);
    LAS float* red = (LAS float*)lds;
    LAS float* stat = (LAS float*)(lds + 4096);
#pragma unroll
    for (int t = 0; t < 32; ++t) {
        a0[t] += db.x; a1[t] += db.y;
        const float s1 = wave_sum(a0[t] + a1[t]), s2 = wave_sum(a0[t] * a0[t] + a1[t] * a1[t]);
        if (lane == 0) { red[(t * 8 + wid) * 2] = s1; red[(t * 8 + wid) * 2 + 1] = s2; }
        if ((t & 3) == 3) __builtin_amdgcn_sched_barrier(0);
    }
    LDS_WAIT(); __syncthreads();
    if (tid < 32) { float s1 = 0.f, s2 = 0.f;
#pragma unroll
        for (int w = 0; w < 8; ++w) { s1 += red[(tid * 8 + w) * 2]; s2 += red[(tid * 8 + w) * 2 + 1]; }
        const float mean = s1 * (1.f / 1024.f), var = s2 * (1.f / 1024.f) - mean * mean;
        stat[tid * 2] = mean; stat[tid * 2 + 1] = rsqrtf(var + LN_EPS); }
    LDS_WAIT(); __syncthreads();
    const f32x2 lg = *(const f32x2*)(ln_g + c), lb = *(const f32x2*)(ln_b + c);
#pragma unroll
    for (int t = 0; t < 32; ++t) {
        const float mean = stat[t * 2], rstd = stat[t * 2 + 1];
        const unsigned gv = __builtin_amdgcn_raw_buffer_load_b32(rs, vo, (unsigned)__builtin_amdgcn_readfirstlane((int)((unsigned)WS_G + (rowbase + (unsigned)(t0 + t)) * 2048u)), 0);
        const float y0 = (a0[t] - mean) * rstd * lg.x + lb.x, y1 = (a1[t] - mean) * rstd * lg.y + lb.y;
        const float o0 = pg8::silu_f(y0) * __uint_as_float(gv << 16), o1 = pg8::silu_f(y1) * __uint_as_float(gv & 0xffff0000u);
        __builtin_amdgcn_raw_buffer_store_b32(pg8::cvt_pk_bf16(o0, o1), rs, vo, (unsigned)__builtin_amdgcn_readfirstlane((int)((unsigned)WS_OA + (rowbase + (unsigned)(t0 + t)) * 2048u)), 0);
        if ((t & 7) == 7) { asm volatile("" ::: "memory"); __builtin_amdgcn_sched_barrier(0); }
    }
    LDS_WAIT(); __syncthreads();
}

__device__ __forceinline__ attn::BlockRef attn_mkref(int Lq, int pass) {
    const int bh = Lq >> 2, xq = Lq & 3, b = bh >> 3, h = bh & 7, qb = pass ? 7 - xq : xq;
    const unsigned r0 = (unsigned)b * SEQ, rq = r0 + (unsigned)qb * 256;
    attn::BlockRef R;
    R.q = (unsigned)WS_Q + (rq * QP + h * 192) * 2u; R.kn = (unsigned)WS_KV + (r0 * KVP + h * 256) * 2u;
    R.kp = (unsigned)WS_ZM + (r0 * ZP + Z_KPE) * 2u; R.o = (unsigned)WS_OA + (rq * 1024 + h * 128) * 2u; R.g = (unsigned)WS_ZM + (rq * ZP + Z_GATE + h * 128) * 2u; R.P0 = qb * 256;
    return R;
}

enum { K_PRO = 0, K_MIN = 1, K_Q = 2, K_KV = 3, K_ATT = 4, K_OUT = 5, K_CIN = 6, K_CMID = 7, K_FIN = 8 };
template <int KIND>
__device__ __forceinline__ void phase(const Args& args, int j, bool first_out, bool is_conv, unsigned char* lds) {
    LAS unsigned char* L = (LAS unsigned char*)lds;
    const int tid = pg8::opaque((int)threadIdx.x), lane = tid & 63, wave = __builtin_amdgcn_readfirstlane(tid >> 6);
    int G = gridDim.x, bx = blockIdx.x; unsigned char* ws = args.ws;
    asm volatile("" : "+s"(G), "+s"(bx), "+s"(ws));
    const int vcu = (G % 8 == 0) ? (bx % 8) * (G / 8) + bx / 8 : bx;
    const int gw = vcu * NWAVES + wave, NGW = G * NWAVES;
    float* SSQ = (float*)(ws + WS_SSQ); float* SSQL = (float*)(ws + WS_SSQL);
    float* COS = (float*)(ws + WS_COS); float* SIN = (float*)(ws + WS_SIN);
    if constexpr (KIND == K_PRO) {
        const float* x_in = (const float*)args.in[0]; bf16u* XB = (bf16u*)(ws + WS_XB);
        LAS float* scr = (LAS float*)(L + RING_OFF + wave * 16384);
        constexpr int I_MIN = 16 * (MLA_IN / 32), I_QB = 6 * (QP / 32), I_KVB = 4 * (KVP / 32), I_O = 16 * 32, I_CIN = 16 * (CONV_IN / 32);
        constexpr int PER = I_MIN + I_QB + I_KVB + I_O + I_CIN + I_O;
        for (int it = gw; it < 2 * PER; it += NGW) {
            const int jj = it / PER; int r = it % PER;
            if (r < I_MIN) { p0_transpose_item<1>((const float*)args.in[4] + (size_t)jj * 1024 * MLA_IN, 1024, MLA_IN, (bf16u*)(ws + WS_WINM + jj * SZ_WINM), (const float*)args.in[3] + jj * 1024, scr, r, lane); continue; } r -= I_MIN;
            if (r < I_QB) { p0_transpose_item<2>((const float*)args.in[6] + (size_t)jj * Q_LORA * QP, Q_LORA, QP, (bf16u*)(ws + WS_WQB + jj * SZ_WQB), (const float*)args.in[5] + jj * Q_LORA, scr, r, lane); continue; } r -= I_QB;
            if (r < I_KVB) { p0_transpose_item<0>((const float*)args.in[8] + (size_t)jj * KV_LORA * KVP, KV_LORA, KVP, (bf16u*)(ws + WS_WKVB + jj * SZ_WKVB), (const float*)args.in[7] + jj * KV_LORA, scr, r, lane); continue; } r -= I_KVB;
            if (r < I_O) { p0_transpose_item<0>((const float*)args.in[9] + (size_t)jj * 1024 * 1024, 1024, 1024, (bf16u*)(ws + WS_WOM + jj * SZ_WO), nullptr, scr, r, lane); continue; } r -= I_O;
            if (r < I_CIN) { p0_transpose_item<3>((const float*)args.in[11] + (size_t)jj * 1024 * CONV_IN, 1024, CONV_IN, (bf16u*)(ws + WS_WINC + jj * SZ_WINC), (const float*)args.in[10] + jj * 1024, scr, r, lane); continue; } r -= I_CIN;
            p0_transpose_item<0>((const float*)args.in[17] + (size_t)jj * 1024 * 1024, 1024, 1024, (bf16u*)(ws + WS_WOC + jj * SZ_WO), nullptr, scr, r, lane);
        }
        for (int i = gw * 64 + lane; i < 2 * 64 * 128; i += NGW * 64) { const int jj = i / (64 * 128), rr = (i / 128) % 64, cc = i % 128;
            *(GAS v4u*)(ws + WS_WINM + jj * SZ_WINM + (size_t)(448 + rr) * 2048 + cc * 16) = (v4u){0u, 0u, 0u, 0u}; }
        for (int m = gw; m < MTOK; m += NGW) {
            const GAS f32x4* xr = (const GAS f32x4*)(x_in + (size_t)m * 1024) + lane; float ss = 0.f; f32x4 v[4];
#pragma unroll
            for (int q = 0; q < 4; ++q) { v[q] = xr[64 * q]; ss += (v[q].x * v[q].x + v[q].y * v[q].y) + (v[q].z * v[q].z + v[q].w * v[q].w); }
            ss = wave_sum(ss);
            GAS unsigned long long* o8 = (GAS unsigned long long*)(XB + (size_t)m * 1024) + lane;
#pragma unroll
            for (int q = 0; q < 4; ++q) o8[64 * q] = (unsigned long long)pk2(v[q].x, v[q].y) | ((unsigned long long)pk2(v[q].z, v[q].w) << 32);
            if (lane == 0) *(f32x4*)(SSQ + (size_t)m * 4) = (f32x4){ss, 0.f, 0.f, 0.f};
        }
        const int* pos = (const int*)args.in[1];
        for (int i = gw * 64 + lane; i < MTOK * 32; i += NGW * 64) {
            const int m = i >> 5, fi = i & 31;
            const float ang = (float)pos[m] * c_inv_freq[fi];
            const double rev = (double)ang * 0.15915494309189535; const float fr = (float)(rev - __builtin_rint(rev));
            COS[i] = __builtin_amdgcn_cosf(fr); SIN[i] = __builtin_amdgcn_sinf(fr);
        }
    }
    if constexpr (KIND == K_FIN) {
        const float* gfin = (const float*)args.in[2]; float* xs = args.out;
        for (int m = gw; m < MTOK; m += NGW) {
            const f32x4 sx = *(const f32x4*)(SSQ + (size_t)m * 4);
            const float rstd = rsqrtf(((sx[0] + sx[1]) + (sx[2] + sx[3])) * (1.0f / 1024.0f) + RMS_EPS);
            GAS f32x4* xr = (GAS f32x4*)(xs + (size_t)m * 1024) + lane;
#pragma unroll
            for (int q = 0; q < 4; ++q) { const f32x4 g4 = *((const f32x4*)gfin + lane + 64 * q); f32x4 v = xr[64 * q]; v = v * rstd * g4; xr[64 * q] = v; }
        }
    }
    if constexpr (KIND == K_MIN) {
        pg8::Gemm g{(const bf16u*)(ws + WS_XB), (const bf16u*)(ws + WS_WINM + j * SZ_WINM), MTOK, ZP, 1024, 1024}; pg8::StaticOrder S; S.init(MTOK, ZP, G, bx);
        pg8::EpiMlaIn E{(bf16u*)(ws + WS_ZM), SSQ, SSQL, COS, SIN};
        pg8::gemm_phase<pg8::EpiMlaIn, pg8::StaticOrder, true, true>(L + RING_OFF, g, S, E);
    }
    if constexpr (KIND == K_Q) {
        pg8::Gemm g{(const bf16u*)(ws + WS_ZM), (const bf16u*)(ws + WS_WQB + j * SZ_WQB), MTOK, QP, Q_LORA, ZP}; pg8::StaticOrder S; S.init(MTOK, QP, G, bx);
        pg8::EpiQ E{(bf16u*)(ws + WS_Q), SSQL, COS, SIN};
        pg8::gemm_phase<pg8::EpiQ, pg8::StaticOrder, true, true>(L + RING_OFF, g, S, E);
    }
    if constexpr (KIND == K_KV) {
        pg8::Gemm g{(const bf16u*)(ws + WS_ZM) + Z_KV, (const bf16u*)(ws + WS_WKVB + j * SZ_WKVB), MTOK, KVP, KV_LORA, ZP}; pg8::StaticOrder S; S.init(MTOK, KVP, G, bx);
        pg8::EpiKV E{(bf16u*)(ws + WS_KV), SSQL};
        pg8::gemm_phase<pg8::EpiKV, pg8::StaticOrder, true, true>(L + RING_OFF, g, S, E);
    }
    if constexpr (KIND == K_ATT) {
        const rsrc_t rs = __builtin_amdgcn_make_buffer_rsrc((void*)ws, 0, (unsigned)WS_END, 0x00020000);
        attn::Seam SM; bool primed = false;
        attn::BlockRef cur{};
        for (int Lq = vcu; Lq < 256; Lq += G) {
            for (int pass = 0; pass < 2; ++pass) {
                if (!primed) { cur = attn_mkref(Lq, pass); attn::attn_prime(cur, rs, (char*)lds, SM); primed = true; }
                const bool last = (pass == 1) && (Lq + G >= 256);
                const attn::BlockRef nxt = last ? cur : (pass == 0 ? attn_mkref(Lq, 1) : attn_mkref(Lq + G, 0));
                attn::attn_block(cur, nxt, rs, (char*)lds, SM);
                cur = nxt;
            }
        }
        asm volatile("s_waitcnt vmcnt(0)" ::: "memory"); __syncthreads();
    }
    if constexpr (KIND == K_OUT) {
        const bf16u* Wt = (const bf16u*)(ws + (is_conv ? WS_WOC : WS_WOM) + j * SZ_WO);
        pg8::Gemm g{(const bf16u*)(ws + WS_OA), Wt, MTOK, 1024, 1024, 1024}; pg8::StaticOrder S; S.init(MTOK, 1024, G, bx);
        pg8::EpiResid E{first_out ? (const float*)args.in[0] : (const float*)args.out, args.out, (bf16u*)(ws + WS_XB), SSQ, is_conv ? (const float*)args.in[18] + j * 1024 : nullptr};
        pg8::gemm_phase<pg8::EpiResid, pg8::StaticOrder, false, true>(L + RING_OFF, g, S, E);
    }
    if constexpr (KIND == K_CIN) {
        pg8::Gemm g{(const bf16u*)(ws + WS_XB), (const bf16u*)(ws + WS_WINC + j * SZ_WINC), MTOK, CONV_IN, 1024, 1024}; pg8::StaticOrder S; S.init(MTOK, CONV_IN, G, bx);
        pg8::EpiConvIn E{(bf16u*)(ws + WS_U), (bf16u*)(ws + WS_G), SSQ, (const float*)args.in[12] + j * CONV_IN};
        pg8::gemm_phase<pg8::EpiConvIn, pg8::StaticOrder, true, true>(L + RING_OFF, g, S, E);
    }
    if constexpr (KIND == K_CMID) {
        const rsrc_t rs = __builtin_amdgcn_make_buffer_rsrc((void*)ws, 0, (unsigned)WS_END, 0x00020000);
        for (int tile = vcu; tile < MTOK / 32; tile += G)
            conv_tile(tile, rs, (const float*)args.in[13] + j * CONV_K * 1024, (const float*)args.in[14] + j * 1024, (const float*)args.in[15] + j * 1024, (const float*)args.in[16] + j * 1024, L + RING_OFF);
    }
}

#if MK_STEPWISE
template <int KIND>
__global__ void __launch_bounds__(NWAVES * 64, 2) step_kernel(Args args) {
    extern __shared__ __attribute__((aligned(16))) unsigned char lds[];
    const int s = args.lo, r7 = (s - 1) % 7, j = (s - 1) / 7;
    phase<KIND>(args, j, s == 4, r7 == 6, lds);
}
template <int KIND> static void launch_step(Args a, int s, int grid, hipStream_t stream) {
    static bool done = false;
    if (!done) { done = true; (void)hipFuncSetAttribute((const void*)step_kernel<KIND>, hipFuncAttributeMaxDynamicSharedMemorySize, LDS_BYTES); }
    a.lo = s; a.hi = s + 1;
    hipLaunchKernelGGL(step_kernel<KIND>, dim3(grid), dim3(NWAVES * 64), LDS_BYTES, stream, a);
}
#else
__global__ void __launch_bounds__(NWAVES * 64, 2) trunk_fwd(Args args) {
    extern __shared__ __attribute__((aligned(16))) unsigned char lds[];
    volatile LAS unsigned* MISC = (volatile LAS unsigned*)((LAS unsigned char*)lds + MISC_OFF);
    if (threadIdx.x < 32) MISC[threadIdx.x] = 0u;
    __syncthreads();
    XcdBarrier bar = xcd_barrier_post((unsigned*)(args.ws + WS_CTL) + CW_BAR, MISC + 8);
    for (int s = args.lo; s < args.hi; ++s) {
        const int r7 = (s - 1) % 7, j = (s - 1) / 7;
        if (s == 0) phase<K_PRO>(args, 0, false, false, lds);
        else if (s == NSTEPS - 1) phase<K_FIN>(args, 0, false, false, lds);
        else if (r7 == 0) phase<K_MIN>(args, j, false, false, lds);
        else if (r7 == 1) { phase<K_Q>(args, j, false, false, lds); phase<K_KV>(args, j, false, false, lds); }
        else if (r7 == 2) phase<K_ATT>(args, j, false, false, lds);
        else if (r7 == 3 || r7 == 6) phase<K_OUT>(args, j, s == 4, r7 == 6, lds);
        else if (r7 == 4) phase<K_CIN>(args, j, false, false, lds);
        else phase<K_CMID>(args, j, false, false, lds);
        if (s + 1 < args.hi) xcd_barrier(bar);
    }
}
#endif

extern "C" void kernel_launch(void* const* d_in, const int* in_sizes, int n_in, void* d_out, int out_size, void* d_ws, size_t ws_size, hipStream_t stream) {
    static int grid = 0;
    if (grid == 0) {
        if (n_in != 19 || in_sizes[0] != MTOK * D_MODEL || out_size != MTOK * D_MODEL || ws_size < WS_END) {
            fprintf(stderr, "kernel_launch: unexpected shapes (n_in %d, in0 %d, out %d, ws %zu); nothing launched\n", n_in, n_in > 0 ? in_sizes[0] : -1, out_size, ws_size); grid = -1; return; }
        int dev = 0, cus = 0;
        if (hipGetDevice(&dev) != hipSuccess || hipDeviceGetAttribute(&cus, hipDeviceAttributeMultiprocessorCount, dev) != hipSuccess) { grid = -1; return; }
#if !MK_STEPWISE
        int per_cu = 0;
        if (hipFuncSetAttribute((const void*)trunk_fwd, hipFuncAttributeMaxDynamicSharedMemorySize, LDS_BYTES) != hipSuccess) { fprintf(stderr, "kernel_launch: hipFuncSetAttribute failed\n"); grid = -1; return; }
        if (hipOccupancyMaxActiveBlocksPerMultiprocessor(&per_cu, (const void*)trunk_fwd, NWAVES * 64, LDS_BYTES) != hipSuccess || per_cu < 1) { fprintf(stderr, "kernel_launch: occupancy query says %d blocks per CU\n", per_cu); (void)hipGetLastError(); }
#endif
        grid = cus;
    }
    if (grid < 0) return;
    Args a{};
    for (int i = 0; i < 19; ++i) a.in[i] = d_in[i];
    a.out = (float*)d_out; a.ws = (unsigned char*)d_ws;
#if MK_STEPWISE
    for (int s = 0; s < NSTEPS; ++s) {
        const int r7 = (s - 1) % 7;
        if (s == 0) launch_step<K_PRO>(a, s, grid, stream);
        else if (s == NSTEPS - 1) launch_step<K_FIN>(a, s, grid, stream);
        else if (r7 == 0) launch_step<K_MIN>(a, s, grid, stream);
        else if (r7 == 1) { launch_step<K_Q>(a, s, grid, stream); launch_step<K_KV>(a, s, grid, stream); }
        else if (r7 == 2) launch_step<K_ATT>(a, s, grid, stream);
        else if (r7 == 3 || r7 == 6) launch_step<K_OUT>(a, s, grid, stream);
        else if (r7 == 4) launch_step<K_CIN>(a, s, grid, stream);
        else launch_step<K_CMID>(a, s, grid, stream);
    }
#else
    if (hipMemsetAsync((char*)d_ws + WS_CTL, 0, CTL_ZERO_BYTES, stream) != hipSuccess) return;
    a.lo = 0; a.hi = NSTEPS;
    void* kargs[] = {&a};
    hipError_t e = hipLaunchCooperativeKernel((const void*)trunk_fwd, dim3(grid), dim3(NWAVES * 64), kargs, LDS_BYTES, stream);
    if (e != hipSuccess) fprintf(stderr, "kernel_launch: cooperative launch failed: %s (grid %d)\n", hipGetErrorString(e), grid);
#endif
}
```

```cpp
#include <hip/hip_runtime.h>
#include <hip/hip_bf16.h>
#include <cstdio>
#include <cstdint>

#ifndef MK_STEPWISE
#define MK_STEPWISE 0
#endif

constexpr int D_MODEL = 1024, BATCH = 8, SEQ = 2048, MTOK = BATCH * SEQ;
constexpr int N_HEADS = 8, QK_NOPE = 128, QK_ROPE = 64, V_HEAD = 128, Q_LORA = 384, KV_LORA = 256;
constexpr int MLA_IN = Q_LORA + KV_LORA + QK_ROPE + N_HEADS * V_HEAD;
constexpr int ZN = 1792;
constexpr int ZP = 768;
constexpr int Z_KPE = 384, Z_KV = 512, Z_GATE = 768;
constexpr int QP = N_HEADS * (QK_NOPE + QK_ROPE);
constexpr int KVP = N_HEADS * (QK_NOPE + V_HEAD);
constexpr int CONV_K = 31, CONV_IN = 3 * D_MODEL;
constexpr float RMS_EPS = 1e-6f, LN_EPS = 1e-5f;

namespace pg8 {
#define PG8_LAS __attribute__((address_space(3)))
typedef unsigned short bf16_t;
typedef short bf16x8 __attribute__((ext_vector_type(8)));
typedef float f32x4 __attribute__((ext_vector_type(4)));
typedef unsigned u32x4 __attribute__((ext_vector_type(4)));
typedef unsigned u32x2 __attribute__((ext_vector_type(2)));
constexpr int BM = 256, BK = 64, HALF = 128, HTB = HALF * BK * 2  , STAGE_BYTES = 8 * HTB, NXCD = 8, WGM = 8;

__host__ __device__ __forceinline__ int lds_byte(int r, int c) { const int st = (r >> 4) * 2 + (c >> 5), rr = r & 15, cc = c & 31, ob = rr * 64 + cc * 2; return st * 1024 + (ob ^ (((ob >> 9) & 1) << 5)); }
__host__ __device__ __forceinline__ void stage_rc(int b, int& R, int& C) { const int st = b / 1024, sb = b % 1024, swz = sb ^ (((sb >> 9) & 1) << 5); R = (st >> 1) * 16 + swz / 64; C = (st & 1) * 32 + (swz % 64) / 2; }
__host__ __device__ __forceinline__ int perm32(int rho) { const int n = rho >> 4, i = rho & 15; return 8 * (i >> 2) + 4 * n + (i & 3); }

struct Unit { int pm, pn; };
struct Gemm { const bf16_t* A; const bf16_t* Bt; int M, N, K, lda; };

struct StaticOrder {
    int nM, nN, nwg, G, c;
    __host__ __device__ void init(int M, int N, int G_, int c_) { nM = M / BM; nN = N / BM; nwg = nM * nN; G = G_; c = c_; }
    __host__ __device__ bool next(int i, Unit& u) const {
        const long L = (long)i * G + c; if (L >= nwg) return false;
        int wgid = (int)L; { const int q = nwg / NXCD, r = nwg % NXCD, xcd = wgid % NXCD, off = wgid / NXCD; wgid = (xcd < r ? xcd * (q + 1) : r * (q + 1) + (xcd - r) * q) + off; }
        const int nig = WGM * nN, gid = wgid / nig, fm = gid * WGM, gsz = (nM - fm) < WGM ? (nM - fm) : WGM;
        u.pm = fm + ((wgid % nig) % gsz); u.pn = (wgid % nig) / gsz; return true;
    }
    __device__ __forceinline__ void a_ready(const Unit&) const {}
    __device__ __forceinline__ void done(const Unit&) const {}
};

__device__ __forceinline__ unsigned cvt_pk_bf16(float lo, float hi) { unsigned r; asm volatile("v_cvt_pk_bf16_f32 %0, %1, %2" : "=v"(r) : "v"(lo), "v"(hi)); return r; }
__device__ __forceinline__ int opaque(int x) { asm volatile("" : "+v"(x)); return x; }
__device__ __forceinline__ float sigmoid_f(float v) { return __builtin_amdgcn_rcpf(1.f + __builtin_amdgcn_exp2f(-1.4426950408889634f * v)); }
__device__ __forceinline__ float silu_f(float v) { return v * sigmoid_f(v); }
__device__ __forceinline__ u32x4 pack8(const f32x4& a, const f32x4& b) { u32x4 w; w.x = cvt_pk_bf16(a[0], a[1]); w.y = cvt_pk_bf16(a[2], a[3]); w.z = cvt_pk_bf16(b[0], b[1]); w.w = cvt_pk_bf16(b[2], b[3]); return w; }
__device__ __forceinline__ float sumsq8(const f32x4& a, const f32x4& b) { return ((a[0] * a[0] + a[1] * a[1]) + (a[2] * a[2] + a[3] * a[3])) + ((b[0] * b[0] + b[1] * b[1]) + (b[2] * b[2] + b[3] * b[3])); }
__device__ __forceinline__ void rope8(f32x4& v0, f32x4& v1, const float* cs, const float* sn, size_t grow, int i0) {
    const f32x4 c = *(const f32x4*)(cs + grow * 32 + i0), s = *(const f32x4*)(sn + grow * 32 + i0);
    const f32x4 a = v0, b = v1;
    v0[0] = a[0] * c[0] - a[1] * s[0]; v0[1] = a[1] * c[0] + a[0] * s[0];
    v0[2] = a[2] * c[1] - a[3] * s[1]; v0[3] = a[3] * c[1] + a[2] * s[1];
    v1[0] = b[0] * c[2] - b[1] * s[2]; v1[1] = b[1] * c[2] + b[0] * s[2];
    v1[2] = b[2] * c[3] - b[3] * s[3]; v1[3] = b[3] * c[3] + b[2] * s[3];
}

struct EpiMlaIn {
    static constexpr bool PERM = true, AFTER_DRAIN = false;
    bf16_t* Z; bf16_t* GO; const float* ssqx; float* ssql; const float* cs; const float* sn;
    __device__ __forceinline__ void operator()(const f32x4 (&acc)[2][2][4][2], const Unit& u, int wr, int wc, int fr_, int fq_) const {
        const int lane_ = opaque((int)(threadIdx.x & 63)), fr = lane_ & 15, fq = lane_ >> 4;
        const int pn = u.pn;
#pragma unroll
        for (int ai = 0; ai < 2; ++ai)
#pragma unroll
            for (int m = 0; m < 4; ++m) {
                const size_t grow = (size_t)(u.pm * BM + ai * HALF + wr * 64 + m * 16 + fr);
                const f32x4 sx = *(const f32x4*)(ssqx + grow * 4);
                const float rstd = rsqrtf(((sx[0] + sx[1]) + (sx[2] + sx[3])) * (1.0f / 1024.0f) + RMS_EPS);
                float s = 0.f;
#pragma unroll
                for (int bj = 0; bj < 2; ++bj) {
                    f32x4 v0 = acc[ai][bj][m][0] * rstd, v1 = acc[ai][bj][m][1] * rstd;
                    const int col0 = pn * BM + bj * HALF + wc * 32 + 8 * fq;
                    bf16_t* dst = Z + grow * ZP + col0;
                    if (pn >= 3) {
#pragma unroll
                        for (int j = 0; j < 4; ++j) { v0[j] = silu_f(v0[j]); v1[j] = silu_f(v1[j]); }
                        *(u32x4*)(GO + grow * 1024 + (col0 - Z_GATE)) = pack8(v0, v1);
                    } else if (pn == 1 && bj == 1) {
                        if (wc < 2) { rope8(v0, v1, cs, sn, grow, 16 * wc + 4 * fq); *(u32x4*)dst = pack8(v0, v1); }
                    } else { s += sumsq8(v0, v1); *(u32x4*)dst = pack8(v0, v1); }
                }
                if (pn <= 2) { s += __shfl_xor(s, 16); s += __shfl_xor(s, 32); if (fq == 0) ssql[grow * 12 + pn * 4 + wc] = s; }
                if (m & 1) asm volatile("" ::: "memory");
            }
    }
};
struct EpiQ {
    static constexpr bool PERM = true, AFTER_DRAIN = false;
    bf16_t* Q; const float* ssql; const float* cs; const float* sn;
    __device__ __forceinline__ void operator()(const f32x4 (&acc)[2][2][4][2], const Unit& u, int wr, int wc, int fr_, int fq_) const {
        const int lane_ = opaque((int)(threadIdx.x & 63)), fr = lane_ & 15, fq = lane_ >> 4;
#pragma unroll
        for (int ai = 0; ai < 2; ++ai)
#pragma unroll
            for (int m = 0; m < 4; ++m) {
                const size_t grow = (size_t)(u.pm * BM + ai * HALF + wr * 64 + m * 16 + fr);
                const f32x4 a = *(const f32x4*)(ssql + grow * 12), b = *(const f32x4*)(ssql + grow * 12 + 4);
                const float rstd = rsqrtf((((a[0] + a[1]) + (a[2] + a[3])) + ((b[0] + b[1]) + (b[2] + b[3]))) * (1.0f / 384.0f) + RMS_EPS);
#pragma unroll
                for (int bj = 0; bj < 2; ++bj) {
                    f32x4 v0 = acc[ai][bj][m][0] * rstd, v1 = acc[ai][bj][m][1] * rstd;
                    const int cw = u.pn * BM + bj * HALF + wc * 32, hd = cw % 192, col0 = cw + 8 * fq;
                    if (hd >= 128) rope8(v0, v1, cs, sn, grow, ((hd - 128) >> 1) + 4 * fq);
                    *(u32x4*)(Q + grow * QP + col0) = pack8(v0, v1);
                }
                asm volatile("" ::: "memory");
            }
    }
};
struct EpiKV {
    static constexpr bool PERM = true, AFTER_DRAIN = false;
    bf16_t* KV; const float* ssql;
    __device__ __forceinline__ void operator()(const f32x4 (&acc)[2][2][4][2], const Unit& u, int wr, int wc, int fr_, int fq_) const {
        const int lane_ = opaque((int)(threadIdx.x & 63)), fr = lane_ & 15, fq = lane_ >> 4;
#pragma unroll
        for (int ai = 0; ai < 2; ++ai)
#pragma unroll
            for (int m = 0; m < 4; ++m) {
                const size_t grow = (size_t)(u.pm * BM + ai * HALF + wr * 64 + m * 16 + fr);
                const f32x4 a = *(const f32x4*)(ssql + grow * 12 + 8);
                const float rstd = rsqrtf(((a[0] + a[1]) + (a[2] + a[3])) * (1.0f / 256.0f) + RMS_EPS);
#pragma unroll
                for (int bj = 0; bj < 2; ++bj) {
                    const f32x4 v0 = acc[ai][bj][m][0] * rstd, v1 = acc[ai][bj][m][1] * rstd;
                    const int col0 = u.pn * BM + bj * HALF + wc * 32 + 8 * fq;
                    *(u32x4*)(KV + grow * KVP + col0) = pack8(v0, v1);
                }
                if (m & 1) asm volatile("" ::: "memory");
            }
    }
};
struct EpiConvIn {
    static constexpr bool PERM = true, AFTER_DRAIN = false;
    bf16_t* U; bf16_t* G; const float* ssqx; const float* bias;
    __device__ __forceinline__ void operator()(const f32x4 (&acc)[2][2][4][2], const Unit& u, int wr, int wc, int fr_, int fq_) const {
        const int lane_ = opaque((int)(threadIdx.x & 63)), fr = lane_ & 15, fq = lane_ >> 4;
        const int pn = u.pn;
#pragma unroll
        for (int ai = 0; ai < 2; ++ai)
#pragma unroll
            for (int m = 0; m < 4; ++m) {
                const size_t grow = (size_t)(u.pm * BM + ai * HALF + wr * 64 + m * 16 + fr);
                const f32x4 sx = *(const f32x4*)(ssqx + grow * 4);
                const float rstd = rsqrtf(((sx[0] + sx[1]) + (sx[2] + sx[3])) * (1.0f / 1024.0f) + RMS_EPS);
#pragma unroll
                for (int bj = 0; bj < 2; ++bj) {
                    f32x4 v0 = acc[ai][bj][m][0] * rstd, v1 = acc[ai][bj][m][1] * rstd;
                    if (pn < 8) {
                        const int c0 = pn * 128 + bj * 64 + wc * 16 + 4 * fq;
                        const f32x4 ba = *(const f32x4*)(bias + c0), bb = *(const f32x4*)(bias + 1024 + c0);
                        const float u0 = (v0[0] + ba[0]) * sigmoid_f(v0[1] + bb[0]), u1 = (v0[2] + ba[1]) * sigmoid_f(v0[3] + bb[1]);
                        const float u2 = (v1[0] + ba[2]) * sigmoid_f(v1[1] + bb[2]), u3 = (v1[2] + ba[3]) * sigmoid_f(v1[3] + bb[3]);
                        u32x2 w; w.x = cvt_pk_bf16(u0, u1); w.y = cvt_pk_bf16(u2, u3);
                        *(u32x2*)(U + grow * 1024 + c0) = w;
                    } else {
                        const int c0 = (pn - 8) * BM + bj * HALF + wc * 32 + 8 * fq;
                        const f32x4 b0 = *(const f32x4*)(bias + 2048 + c0), b1 = *(const f32x4*)(bias + 2048 + c0 + 4);
#pragma unroll
                        for (int j = 0; j < 4; ++j) { v0[j] = silu_f(v0[j] + b0[j]); v1[j] = silu_f(v1[j] + b1[j]); }
                        *(u32x4*)(G + grow * 1024 + c0) = pack8(v0, v1);
                    }
                }
                if (m & 1) asm volatile("" ::: "memory");
            }
    }
};
struct EpiResid {
    static constexpr bool PERM = true, AFTER_DRAIN = true;
    const bf16_t* xin; bf16_t* xbo; float* xf32; float* ssq; const float* bias;
    __device__ __forceinline__ void fused(f32x4 (&acc)[2][2][4][2], const Unit& u, int wr, int wc, int fr_, int fq_, PG8_LAS unsigned char* lds, int wid, int lane) const {
        const int lane_ = opaque(lane), fr = lane_ & 15, fq = lane_ >> 4;
        PG8_LAS float* P = (PG8_LAS float*)lds;
#pragma unroll
        for (int ai = 0; ai < 2; ++ai)
#pragma unroll
            for (int m = 0; m < 4; ++m) {
                const int rt = ai * HALF + wr * 64 + m * 16 + fr;
                const size_t grow = (size_t)(u.pm * BM + rt);
                float s = 0.f;
#pragma unroll
                for (int bj = 0; bj < 2; ++bj) {
                    const int col0 = u.pn * BM + bj * HALF + wc * 32 + 8 * fq;
                    const u32x4 xo = *(const u32x4*)(xin + grow * 1024 + col0);
                    f32x4 v0 = acc[ai][bj][m][0], v1 = acc[ai][bj][m][1];
                    v0[0] += __uint_as_float(xo[0] << 16); v0[1] += __uint_as_float(xo[0] & 0xffff0000u); v0[2] += __uint_as_float(xo[1] << 16); v0[3] += __uint_as_float(xo[1] & 0xffff0000u);
                    v1[0] += __uint_as_float(xo[2] << 16); v1[1] += __uint_as_float(xo[2] & 0xffff0000u); v1[2] += __uint_as_float(xo[3] << 16); v1[3] += __uint_as_float(xo[3] & 0xffff0000u);
                    if (bias) { v0 += *(const f32x4*)(bias + col0); v1 += *(const f32x4*)(bias + col0 + 4); }
                    if (xf32) { *(f32x4*)(xf32 + grow * 1024 + col0) = v0; *(f32x4*)(xf32 + grow * 1024 + col0 + 4) = v1; }
                    *(u32x4*)(xbo + grow * 1024 + col0) = pack8(v0, v1);
                    s += sumsq8(v0, v1);
                }
                s += __shfl_xor(s, 16); s += __shfl_xor(s, 32);
                if (fq == 0) P[rt * 4 + wc] = s;
                if (m & 1) asm volatile("" ::: "memory");
            }
        asm volatile("s_waitcnt lgkmcnt(0)" ::: "memory"); __builtin_amdgcn_s_barrier(); asm volatile("" ::: "memory");
        const int t = wid * 64 + lane;
        if (t < 256) { const PG8_LAS f32x4* p4 = (const PG8_LAS f32x4*)P; const f32x4 p = p4[t]; ssq[(size_t)(u.pm * BM + t) * 4 + u.pn] = (p[0] + p[1]) + (p[2] + p[3]); }
        asm volatile("s_waitcnt lgkmcnt(0)" ::: "memory"); __builtin_amdgcn_s_barrier(); asm volatile("" ::: "memory");
    }
};

__device__ __forceinline__ f32x4 zero4() { float z = 0.f; asm volatile("" : "+v"(z)); return (f32x4){z, z, z, z}; }
template <class Epi, class Sched, bool ALIGN_EPI = false, bool SP2 = false>
__device__ __forceinline__ void gemm_phase(PG8_LAS unsigned char* lds, const Gemm g, const Sched& S, const Epi& E) {
    const int tid = opaque((int)threadIdx.x), wid = __builtin_amdgcn_readfirstlane(tid >> 6), lane = tid & 63, wr = wid >> 2, wc = wid & 3, fr = lane & 15, fq = lane >> 4;
    const int K = g.K, nt = K / BK, lda = g.lda;
    unsigned voffA[2], voffB[2];
#pragma unroll
    for (int i = 0; i < 2; ++i) { int R, C; stage_rc(tid * 16 + i * 8192, R, C); const int Rb = Epi::PERM ? ((R & ~31) + perm32(R & 31)) : R;
        voffA[i] = (unsigned)(R * lda + C) * 2u; voffB[i] = (unsigned)(Rb * K + C) * 2u; }
    const size_t kstep = (size_t)(BK * 2);
    const size_t hstepA = (size_t)HALF * lda * 2, hstepB = (size_t)HALF * K * 2;
    const size_t tstepA = 2 * hstepA, tstepB = 2 * hstepB;
    const unsigned ldsw = (unsigned)wid * 1024u;
    const int aoff = lds_byte(wr * 64 + fr, fq * 8), boff = lds_byte(wc * 32 + fr, fq * 8);
#define PG8_SA(b, h) (((b) * 2 + (h)) * HTB)
#define PG8_SB(b, h) ((4 + (b) * 2 + (h)) * HTB)
#define PG8_STAGE(bufoff, gbase, voff) do { _Pragma("unroll") for (int _i = 0; _i < 2; ++_i) \
        __builtin_amdgcn_global_load_lds((const unsigned*)((const char*)(gbase) + (voff)[_i]), (PG8_LAS unsigned*)(lds + (bufoff) + ldsw + _i * 8192), 16, 0, 0); } while (0)
#define PG8_LDA(dst, b, h) do { _Pragma("unroll") for (int m = 0; m < 4; ++m) _Pragma("unroll") for (int k = 0; k < 2; ++k) dst[m][k] = *(const PG8_LAS bf16x8*)(lds + PG8_SA(b, h) + aoff + m * 2048 + k * 1024); } while (0)
#define PG8_LDB(dst, b, h) do { _Pragma("unroll") for (int n = 0; n < 2; ++n) _Pragma("unroll") for (int k = 0; k < 2; ++k) dst[n][k] = *(const PG8_LAS bf16x8*)(lds + PG8_SB(b, h) + boff + n * 2048 + k * 1024); } while (0)
#define PG8_MMA(ai, bj, At, Bt) do { __builtin_amdgcn_s_setprio(1); _Pragma("unroll") for (int m = 0; m < 4; ++m) _Pragma("unroll") for (int n = 0; n < 2; ++n) _Pragma("unroll") for (int k = 0; k < 2; ++k) \
        acc[ai][bj][m][n] = __builtin_amdgcn_mfma_f32_16x16x32_bf16(Bt[n][k], At[m][k], acc[ai][bj][m][n], 0, 0, 0); __builtin_amdgcn_s_setprio(0); } while (0)
#define PG8_WAIT_V(n) asm volatile("s_waitcnt vmcnt(" #n ")" ::: "memory")
#define PG8_WAIT_L(n) asm volatile("s_waitcnt lgkmcnt(" #n ")" ::: "memory")
#define PG8_BAR __builtin_amdgcn_s_barrier()
#define PG8_SCHED __builtin_amdgcn_sched_barrier(0)
    Unit cur, nxt; int ui = 0;
    if (!S.next(0, cur)) return;
    f32x4 acc[2][2][4][2];
#pragma unroll
    for (int a = 0; a < 2; ++a)
#pragma unroll
        for (int b = 0; b < 2; ++b)
#pragma unroll
            for (int m = 0; m < 4; ++m)
#pragma unroll
                for (int n = 0; n < 2; ++n) acc[a][b][m][n] = zero4();
    bf16x8 At[4][2] = {}, B0[2][2] = {}, B1[2][2] = {};
    const char* cA = (const char*)g.A + (size_t)cur.pm * tstepA; const char* cB = (const char*)g.Bt + (size_t)cur.pn * tstepB;
    S.a_ready(cur);
    if constexpr (SP2) {
        PG8_STAGE(PG8_SB(0, 0), cB, voffB); PG8_STAGE(PG8_SB(0, 1), cB + hstepB, voffB); PG8_STAGE(PG8_SA(0, 0), cA, voffA); PG8_STAGE(PG8_SA(0, 1), cA + hstepA, voffA);
        if (wr == 1) PG8_BAR;
        PG8_WAIT_V(2); PG8_BAR;
        PG8_STAGE(PG8_SB(1, 0), cB + kstep, voffB); PG8_STAGE(PG8_SA(1, 0), cA + kstep, voffA); PG8_STAGE(PG8_SB(1, 1), cB + hstepB + kstep, voffB);
        PG8_WAIT_V(6); PG8_BAR;
    } else {
        PG8_STAGE(PG8_SB(0, 0), cB, voffB); PG8_STAGE(PG8_SA(0, 0), cA, voffA); PG8_STAGE(PG8_SB(0, 1), cB + hstepB, voffB); PG8_STAGE(PG8_SA(0, 1), cA + hstepA, voffA);
        if (wr == 1) PG8_BAR;
        PG8_WAIT_V(4); PG8_BAR;
        PG8_STAGE(PG8_SB(1, 0), cB + kstep, voffB); PG8_STAGE(PG8_SA(1, 0), cA + kstep, voffA); PG8_STAGE(PG8_SB(1, 1), cB + hstepB + kstep, voffB);
        PG8_WAIT_V(6); PG8_BAR;
    }
    for (;;) {
        const bool has_next = S.next(ui + 1, nxt);
        const char* nA = has_next ? (const char*)g.A + (size_t)nxt.pm * tstepA : cA; const char* nB = has_next ? (const char*)g.Bt + (size_t)nxt.pn * tstepB : cB;
#pragma nounroll
        for (int t = 0; t < nt; t += 2) {
            const bool last = (t == nt - 2);
            const char* a1 = cA + (size_t)(t + 1) * kstep;
            const char* a2 = last ? nA : cA + (size_t)(t + 2) * kstep; const char* b2 = last ? nB : cB + (size_t)(t + 2) * kstep;
            const char* a3 = a2 + kstep; const char* b3 = b2 + kstep;
            if (last && has_next) S.a_ready(nxt);
            if constexpr (SP2) {
            PG8_LDB(B0, 0, 0); PG8_LDB(B1, 0, 1); PG8_SCHED; PG8_LDA(At, 0, 0); PG8_STAGE(PG8_SA(1, 1), a1 + hstepA, voffA);
            PG8_WAIT_V(8); PG8_WAIT_L(0); PG8_BAR; PG8_MMA(0, 0, At, B0); PG8_MMA(0, 1, At, B1); PG8_BAR; PG8_SCHED;
            PG8_LDA(At, 0, 1); PG8_STAGE(PG8_SB(0, 0), b2, voffB); PG8_STAGE(PG8_SB(0, 1), b2 + hstepB, voffB); PG8_STAGE(PG8_SA(0, 0), a2, voffA);
            PG8_WAIT_V(8); PG8_WAIT_L(0); PG8_BAR; PG8_MMA(1, 0, At, B0); PG8_MMA(1, 1, At, B1); PG8_BAR; PG8_SCHED;
            PG8_LDB(B0, 1, 0); PG8_LDB(B1, 1, 1); PG8_SCHED; PG8_LDA(At, 1, 0); PG8_STAGE(PG8_SA(0, 1), a2 + hstepA, voffA);
            PG8_WAIT_V(8); PG8_WAIT_L(0); PG8_BAR; PG8_MMA(0, 0, At, B0); PG8_MMA(0, 1, At, B1); PG8_BAR; PG8_SCHED;
            PG8_LDA(At, 1, 1); PG8_STAGE(PG8_SB(1, 0), b3, voffB); PG8_STAGE(PG8_SB(1, 1), b3 + hstepB, voffB); PG8_STAGE(PG8_SA(1, 0), a3, voffA);
            PG8_WAIT_V(8); PG8_WAIT_L(0); PG8_BAR; PG8_MMA(1, 0, At, B0); PG8_MMA(1, 1, At, B1); PG8_BAR; PG8_SCHED;
            } else {
            PG8_LDB(B0, 0, 0); PG8_SCHED; PG8_LDA(At, 0, 0); PG8_STAGE(PG8_SA(1, 1), a1 + hstepA, voffA);
            PG8_WAIT_L(8); PG8_BAR; PG8_WAIT_L(0); PG8_MMA(0, 0, At, B0); PG8_BAR; PG8_SCHED;
            PG8_LDB(B1, 0, 1); PG8_STAGE(PG8_SB(0, 0), b2, voffB);
            PG8_BAR; PG8_WAIT_L(0); PG8_MMA(0, 1, At, B1); PG8_BAR;
            PG8_LDA(At, 0, 1); PG8_STAGE(PG8_SA(0, 0), a2, voffA);
            PG8_BAR; PG8_WAIT_L(0); PG8_MMA(1, 0, At, B0); PG8_BAR; PG8_SCHED;
            PG8_STAGE(PG8_SB(0, 1), b2 + hstepB, voffB);
            PG8_WAIT_V(6); PG8_BAR; PG8_MMA(1, 1, At, B1); PG8_BAR;
            PG8_LDB(B0, 1, 0); PG8_SCHED; PG8_LDA(At, 1, 0); PG8_STAGE(PG8_SA(0, 1), a2 + hstepA, voffA);
            PG8_WAIT_L(8); PG8_BAR; PG8_WAIT_L(0); PG8_MMA(0, 0, At, B0); PG8_BAR; PG8_SCHED;
            PG8_LDB(B1, 1, 1); PG8_STAGE(PG8_SB(1, 0), b3, voffB);
            PG8_BAR; PG8_WAIT_L(0); PG8_MMA(0, 1, At, B1); PG8_BAR;
            PG8_LDA(At, 1, 1); PG8_STAGE(PG8_SA(1, 0), a3, voffA);
            PG8_BAR; PG8_WAIT_L(0); PG8_MMA(1, 0, At, B0); PG8_BAR; PG8_SCHED;
            PG8_STAGE(PG8_SB(1, 1), b3 + hstepB, voffB);
            PG8_WAIT_V(6); PG8_BAR; PG8_MMA(1, 1, At, B1); PG8_BAR;
            }
        }
        if constexpr (ALIGN_EPI) { if (wr == 0) PG8_BAR; }
        if constexpr (!Epi::AFTER_DRAIN) { E(acc, cur, wr, wc, fr, fq); S.done(cur); }
        if (!has_next) break;
#pragma unroll
        for (int a = 0; a < 2; ++a)
#pragma unroll
            for (int b = 0; b < 2; ++b)
#pragma unroll
                for (int m = 0; m < 4; ++m)
#pragma unroll
                    for (int n = 0; n < 2; ++n) acc[a][b][m][n] = zero4();
        cur = nxt; cA = nA; cB = nB; ++ui;
        if constexpr (ALIGN_EPI) { if (wr == 1) PG8_BAR; }
    }
    PG8_WAIT_V(0);
    if constexpr (!ALIGN_EPI) { if (wr == 0) PG8_BAR; }
    PG8_BAR;
    if constexpr (Epi::AFTER_DRAIN) { E.fused(acc, cur, wr, wc, fr, fq, lds, wid, lane); S.done(cur); }
#undef PG8_SA
#undef PG8_SB
#undef PG8_STAGE
#undef PG8_LDA
#undef PG8_LDB
#undef PG8_MMA
#undef PG8_WAIT_V
#undef PG8_WAIT_L
#undef PG8_BAR
#undef PG8_SCHED
}
}

namespace attn {
using bf16 = __hip_bfloat16;
typedef short bf16x8 __attribute__((ext_vector_type(8)));
typedef short s16x4 __attribute__((ext_vector_type(4)));
typedef float f32x16 __attribute__((ext_vector_type(16)));
typedef float f32x4 __attribute__((ext_vector_type(4)));
typedef unsigned u32x4 __attribute__((ext_vector_type(4)));
constexpr int D = 128, DQK = 192;
constexpr float THR = 8.f;
constexpr float SCALE = 0.07216878364870322f;
constexpr int NW = 8, QBLK = 32, KVBLK = 64, QB = NW * QBLK;
constexpr int SHM_V = KVBLK * D * 2, SHM_K = KVBLK * D * 2, SHM_KP = KVBLK * 64 * 2;
constexpr int OFF_K = 2 * SHM_V, OFF_KP = OFF_K + 2 * SHM_K, OFF_WS = OFF_KP + 2 * SHM_KP, OFF_OST = OFF_WS + NW * 64 * 4, LDS_BYTES = OFF_OST + NW * 8192;
constexpr int NQD = DQK / 16;

#define KSWZ(row, colB) ((row) * 256 + ((colB) ^ (((row) & 7) << 4)))
#define SBAR() __builtin_amdgcn_sched_barrier(0)
__device__ __forceinline__ int v_st(int k, int c) { const int kk = (k & ~0xC) | ((k & 4) << 1) | ((k & 8) >> 1); return ((kk >> 3) * 4 + (c >> 5)) * 512 + ((kk & 7) * 32 + (c & 31)) * 2; }
__device__ __forceinline__ int v_rd_base(int lane) { return ((lane & 3) << 3) | (((lane >> 2) & 3) << 6) | (((lane >> 4) & 1) << 5) | (((lane >> 5) & 1) << 8); }
constexpr int v_rd_off(int d0, int ks, int half) { return d0 * 512 + ks * 4096 + half * 2048; }
__device__ __forceinline__ int crow(int r, int hi) { return (r & 3) + 8 * (r >> 2) + 4 * hi; }
__device__ __forceinline__ unsigned cvtpk(float lo, float hi) { unsigned r; asm volatile("v_cvt_pk_bf16_f32 %0, %1, %2" : "=v"(r) : "v"(lo), "v"(hi)); return r; }
__device__ __forceinline__ int opaque(int x) { asm volatile("" : "+v"(x)); return x; }
__device__ __forceinline__ bf16x8 load8(const bf16* p) { return *reinterpret_cast<const bf16x8*>(p); }
__device__ __forceinline__ void mask_tile(f32x16& p0, f32x16& p1, int dq) {
    const float NEG = -__builtin_inff();
#pragma unroll
    for (int r = 0; r < 16; ++r) {
        const int c = (r & 3) + 8 * (r >> 2);
        if (dq - c < 0) p0[r] = NEG;
        if (dq - c - 32 < 0) p1[r] = NEG;
    }
}
__device__ __forceinline__ void partialSM(f32x16& p0, f32x16& p1, float& m_reg, float& mn, float& alpha) {
    float pmax = p0[0];
#pragma unroll
    for (int r = 1; r < 16; ++r) pmax = fmaxf(pmax, p0[r]);
#pragma unroll
    for (int r = 0; r < 16; ++r) pmax = fmaxf(pmax, p1[r]);
    { auto rr = __builtin_amdgcn_permlane32_swap(__float_as_uint(pmax), __float_as_uint(pmax), false, false);
      pmax = fmaxf(__uint_as_float(rr[0]), __uint_as_float(rr[1])); }
    constexpr float C2 = 1.4426950408889634f * SCALE;
    if (__builtin_expect(__all((pmax - m_reg) * SCALE <= THR), 1)) { mn = m_reg; alpha = 1.f; }
    else { mn = fmaxf(m_reg, pmax); alpha = __builtin_amdgcn_exp2f((m_reg - mn) * C2); m_reg = mn; }
    const float mnL = -mn * C2;
#pragma unroll
    for (int r = 0; r < 16; ++r) p0[r] = fmaf(p0[r], C2, mnL);
#pragma unroll
    for (int r = 0; r < 16; ++r) p1[r] = fmaf(p1[r], C2, mnL);
#pragma unroll
    for (int r = 0; r < 16; ++r) p0[r] = __builtin_amdgcn_exp2f(p0[r]);
}
__device__ __forceinline__ void finishSM(f32x16& p0, f32x16& p1, float alpha, float& l_reg, bf16x8& pa0, bf16x8& pa1, bf16x8& pa2, bf16x8& pa3) {
#pragma unroll
    for (int r = 0; r < 16; ++r) p1[r] = __builtin_amdgcn_exp2f(p1[r]);
    float ps = 0;
#pragma unroll
    for (int r = 0; r < 16; ++r) ps += p0[r];
#pragma unroll
    for (int r = 0; r < 16; ++r) ps += p1[r];
    { auto rr = __builtin_amdgcn_permlane32_swap(__float_as_uint(ps), __float_as_uint(ps), false, false);
      ps = __uint_as_float(rr[0]) + __uint_as_float(rr[1]); }
    l_reg = l_reg * alpha + ps;
#define PK4(P, B_, OUT) do { unsigned a0 = cvtpk(P[B_+0], P[B_+1]), a1 = cvtpk(P[B_+2], P[B_+3]);                          \
        unsigned b0 = cvtpk(P[B_+4], P[B_+5]), b1 = cvtpk(P[B_+6], P[B_+7]);                                             \
        auto r0 = __builtin_amdgcn_permlane32_swap(a0, b0, false, false); auto r1 = __builtin_amdgcn_permlane32_swap(a1, b1, false, false); \
        u32x4 w = {r0[0], r1[0], r0[1], r1[1]}; OUT = *reinterpret_cast<bf16x8*>(&w); } while (0)
    PK4(p0, 0, pa0); PK4(p0, 8, pa1); PK4(p1, 0, pa2); PK4(p1, 8, pa3);
#undef PK4
}
template <int KB>
__device__ __forceinline__ void qkt(f32x16& p0, f32x16& p1, const char* K_lds, int r32, int hi, const bf16x8* qr, const char* qpl) {
    p0 = f32x16{}; p1 = f32x16{};
    const char* kb[4];
#pragma unroll
    for (int dd = 0; dd < 4; ++dd) kb[dd] = K_lds + KB * SHM_K + KSWZ(r32, (dd * 16 + hi * 8) * 2);
#pragma unroll
    for (int d0 = 0; d0 < 8; ++d0) { const char* a = kb[d0 & 3] + (d0 >> 2) * 128;
        bf16x8 b0 = *reinterpret_cast<const bf16x8*>(a);
        bf16x8 b1 = *reinterpret_cast<const bf16x8*>(a + 32 * 256);
        p0 = __builtin_amdgcn_mfma_f32_32x32x16_bf16(b0, qr[d0], p0, 0, 0, 0);
        p1 = __builtin_amdgcn_mfma_f32_32x32x16_bf16(b1, qr[d0], p1, 0, 0, 0); }
#pragma unroll
    for (int e = 0; e < 4; ++e) { const char* a = kb[e] + (2 * SHM_K - KB * SHM_K + KB * SHM_KP);
        bf16x8 b0 = *reinterpret_cast<const bf16x8*>(a);
        bf16x8 b1 = *reinterpret_cast<const bf16x8*>(a + 128);
        const bf16x8 qe = *reinterpret_cast<const bf16x8*>(qpl + e * 1024);
        p0 = __builtin_amdgcn_mfma_f32_32x32x16_bf16(b0, qe, p0, 0, 0, 0);
        p1 = __builtin_amdgcn_mfma_f32_32x32x16_bf16(b1, qe, p1, 0, 0, 0); }
}
template <int VB>
__device__ __forceinline__ void pv_tile(f32x16* o, int vb0, bf16x8 pa0, bf16x8 pa1, bf16x8 pa2, bf16x8 pa3) {
#define TRRD(dst, off) asm volatile("ds_read_b64_tr_b16 %0, %1 offset:%2" : "=&v"(dst) : "v"(vb0), "i"(off) : "memory")
#define PV_D0(d0) do { s16x4 l0, l1, l2, l3, h0, h1, h2, h3; constexpr int b_ = VB * SHM_V + v_rd_off(d0, 0, 0);     \
        TRRD(l0, b_); TRRD(h0, b_ + 2048); TRRD(l1, b_ + 4096); TRRD(h1, b_ + 6144); TRRD(l2, b_ + 8192); TRRD(h2, b_ + 10240); TRRD(l3, b_ + 12288); TRRD(h3, b_ + 14336); \
        asm volatile("s_waitcnt lgkmcnt(0)" ::: "memory"); SBAR();                                                                  \
        o[d0] = __builtin_amdgcn_mfma_f32_32x32x16_bf16(pa0, (bf16x8){l0[0], l0[1], l0[2], l0[3], h0[0], h0[1], h0[2], h0[3]}, o[d0], 0, 0, 0);   \
        o[d0] = __builtin_amdgcn_mfma_f32_32x32x16_bf16(pa1, (bf16x8){l1[0], l1[1], l1[2], l1[3], h1[0], h1[1], h1[2], h1[3]}, o[d0], 0, 0, 0);   \
        o[d0] = __builtin_amdgcn_mfma_f32_32x32x16_bf16(pa2, (bf16x8){l2[0], l2[1], l2[2], l2[3], h2[0], h2[1], h2[2], h2[3]}, o[d0], 0, 0, 0);   \
        o[d0] = __builtin_amdgcn_mfma_f32_32x32x16_bf16(pa3, (bf16x8){l3[0], l3[1], l3[2], l3[3], h3[0], h3[1], h3[2], h3[3]}, o[d0], 0, 0, 0); } while (0)
    PV_D0(0); PV_D0(1); PV_D0(2); PV_D0(3);
#undef PV_D0
#undef TRRD
}

typedef __amdgpu_buffer_rsrc_t rsrc_t;
struct BlockRef { unsigned q, kn, kp, o; int P0; };
struct Seam { bf16x8 qr[8]; bf16x8 qpe[4]; bf16x8 st_v0, st_v1, st_k0, st_k1, st_kp; };
__device__ __forceinline__ bf16x8 bld8(rsrc_t r, unsigned voff, unsigned soff) { const u32x4 v = __builtin_amdgcn_raw_buffer_load_b128(r, voff, soff, 0); return __builtin_bit_cast(bf16x8, v); }
#define VMW() asm volatile("s_waitcnt vmcnt(0)" ::: "memory")
#define VMWN(n) asm volatile("s_waitcnt vmcnt(%0)" :: "i"(n) : "memory")
#define SLOAD(R, k0) do { const unsigned so_ = (R).kn + (unsigned)(k0) * (KVP * 2), sp_ = (R).kp + (unsigned)(k0) * (ZP * 2);                       \
                          S.st_v0 = bld8(rs, vkv + 256, so_); S.st_v1 = bld8(rs, vkv + 256, so_ + 32 * KVP * 2);                                   \
                          S.st_k0 = bld8(rs, vkv, so_); S.st_k1 = bld8(rs, vkv, so_ + 32 * KVP * 2);                                               \
                          S.st_kp = bld8(rs, vkp, sp_); } while (0)
#define QLOAD(R) do { _Pragma("unroll") for (int d0 = 0; d0 < 8; ++d0) S.qr[d0] = bld8(rs, vq + d0 * 32, (R).q); } while (0)
#define QPLOAD(R) do { _Pragma("unroll") for (int e = 0; e < 4; ++e) S.qpe[e] = bld8(rs, vq + (8 + e) * 32, (R).q); } while (0)
#define QPWRITE() do { _Pragma("unroll") for (int e = 0; e < 4; ++e) *(bf16x8*)(qpl + e * 1024) = S.qpe[e]; } while (0)
#define SWRITE_K(bf) do { *(bf16x8*)(K_lds + (bf) * SHM_K + kws) = S.st_k0; *(bf16x8*)(K_lds + (bf) * SHM_K + kws + 32 * 256) = S.st_k1; \
                          *(bf16x8*)(KP_lds + (bf) * SHM_KP + kpw) = S.st_kp; } while (0)
#define SWRITE_V(bf) do { *(bf16x8*)(V_lds + (bf) * SHM_V + vst0) = S.st_v0; *(bf16x8*)(V_lds + (bf) * SHM_V + vst1) = S.st_v1; } while (0)
#define SWRITE_ALL(bf) do { SWRITE_V(bf); SWRITE_K(bf); } while (0)
__device__ __forceinline__ void attn_prime(const BlockRef& cur, rsrc_t rs, char* lds, Seam& S) {
    const int tid = opaque(threadIdx.x), wid = __builtin_amdgcn_readfirstlane(tid >> 6), lane = tid & 63, r32 = lane & 31, hi = lane >> 5;
    const int sr = tid >> 4, sc = (tid & 15) * 8, kws = KSWZ(sr, sc * 2), pr = tid >> 3, pc = tid & 7, kpw = KSWZ(pr & 31, ((pr >> 5) * 8 + pc) * 16);
    const unsigned vq = (unsigned)((wid * QBLK + r32) * QP + hi * 8) * 2u, vkv = (unsigned)(sr * KVP + sc) * 2u, vkp = (unsigned)(pr * ZP + pc * 8) * 2u;
    char* K_lds = lds + OFF_K; char* KP_lds = lds + OFF_KP;
    char* qpl = lds + OFF_OST + wid * 8192 + lane * 16;
    QLOAD(cur); QPLOAD(cur);
    SLOAD(cur, 0); VMW(); SWRITE_K(0); QPWRITE();
    __syncthreads();
}
__device__ __forceinline__ void attn_block(const BlockRef& cur, const BlockRef& nxt, rsrc_t rs, char* lds, Seam& S) {
    const int tid = opaque(threadIdx.x), wid = __builtin_amdgcn_readfirstlane(tid >> 6), lane = tid & 63, r32 = lane & 31, hi = lane >> 5;
    const int NT = (cur.P0 + QB) / KVBLK;
    const int qlo = cur.P0 + wid * QBLK, qm = qlo + r32 - 4 * hi;
    char* V_lds = lds; char* K_lds = lds + OFF_K; char* KP_lds = lds + OFF_KP;
    float* ws = (float*)(lds + OFF_WS) + wid * 64; float* li_l = ws, * al_l = ws + 32;
    float m_reg = -1e30f, l_reg = 0; f32x16 o[4] = {};
    const int sr = tid >> 4, sc = (tid & 15) * 8, vst0 = v_st(sr, sc), vst1 = v_st(32 + sr, sc), kws = KSWZ(sr, sc * 2);
    const int pr = tid >> 3, pc = tid & 7, kpw = KSWZ(pr & 31, ((pr >> 5) * 8 + pc) * 16);
    const int vb0 = (int)(uintptr_t)V_lds + v_rd_base(lane);
    char* qpl = lds + OFF_OST + wid * 8192 + lane * 16;
    const unsigned vkv = (unsigned)(sr * KVP + sc) * 2u, vkp = (unsigned)(pr * ZP + pc * 8) * 2u;
#define RESC(a) do { if (__any((a) < 1.f)) { if (hi == 0) al_l[r32] = (a); asm volatile("s_waitcnt lgkmcnt(0)" ::: "memory");              \
                     for (int d_ = 0; d_ < 4; ++d_) for (int r = 0; r < 16; ++r) o[d_][r] *= al_l[crow(r, hi)]; } } while (0)
#define KBASE(t) ((t) * KVBLK)
#define MASKT(P0_, P1_, t) do { const int kb_ = KBASE(t); if (kb_ + KVBLK - 1 > qlo) mask_tile(P0_, P1_, qm - kb_); } while (0)
    f32x16 pA0, pA1, pB0, pB1; float mnA, mnB, alA, alB; bf16x8 pa0, pa1, pa2, pa3;
    SWRITE_V(0); SBAR();
    if (NT > 1) { SLOAD(cur, KBASE(1)); }
    SBAR(); qkt<0>(pA0, pA1, K_lds, r32, hi, S.qr, qpl);
    MASKT(pA0, pA1, 0); partialSM(pA0, pA1, m_reg, mnA, alA);
    if (NT > 1) { VMW(); SWRITE_ALL(1); }
    __syncthreads();
#define HALF_STEP(PX0, PX1, mnX, alX, PY0, PY1, alY, t, KB, VB, SB) do {                                                      \
        SBAR(); qkt<KB>(PX0, PX1, K_lds, r32, hi, S.qr, qpl);                                                                      \
        finishSM(PY0, PY1, alY, l_reg, pa0, pa1, pa2, pa3); SBAR();                                                           \
        if ((t) + 1 < NT) { SLOAD(cur, KBASE((t) + 1)); SBAR(); }                                                             \
        pv_tile<VB>(o, vb0, pa0, pa1, pa2, pa3); MASKT(PX0, PX1, (t)); partialSM(PX0, PX1, m_reg, mnX, alX);                  \
        __syncthreads();                                                                                                      \
        if ((t) + 1 < NT) { VMW(); SWRITE_ALL(SB); }                                                                          \
        RESC(alX); __syncthreads(); } while (0)
    for (int t = 1; t + 1 < NT; t += 2) {
        HALF_STEP(pB0, pB1, mnB, alB, pA0, pA1, alA, t, 1, 0, 0);
        HALF_STEP(pA0, pA1, mnA, alA, pB0, pB1, alB, t + 1, 0, 1, 1);
    }
    SBAR(); qkt<1>(pB0, pB1, K_lds, r32, hi, S.qr, qpl); SBAR();
    finishSM(pA0, pA1, alA, l_reg, pa0, pa1, pa2, pa3); SBAR();
    pv_tile<0>(o, vb0, pa0, pa1, pa2, pa3);
    SBAR(); { const int l2 = opaque(lane); const unsigned vq = (unsigned)((wid * QBLK + (l2 & 31)) * QP + (l2 >> 5) * 8) * 2u; QLOAD(nxt); } SLOAD(nxt, 0); SBAR();
    MASKT(pB0, pB1, NT - 1); partialSM(pB0, pB1, m_reg, mnB, alB); __syncthreads(); RESC(alB);
    finishSM(pB0, pB1, alB, l_reg, pa0, pa1, pa2, pa3); SBAR(); pv_tile<1>(o, vb0, pa0, pa1, pa2, pa3);
    SBAR(); { const int l2 = opaque(lane); const unsigned vq = (unsigned)((wid * QBLK + (l2 & 31)) * QP + (l2 >> 5) * 8) * 2u; QPLOAD(nxt); }
    SBAR(); VMWN(4); SWRITE_K(0); SBAR();
    if (hi == 0) li_l[r32] = l_reg; asm volatile("s_waitcnt lgkmcnt(0)" ::: "memory");
    float rli[16];
#pragma unroll
    for (int r = 0; r < 16; ++r) rli[r] = __builtin_amdgcn_rcpf(li_l[crow(r, hi)]);
    bf16* stg = (bf16*)(lds + OFF_OST) + wid * 4096;
#pragma unroll
    for (int r = 0; r < 16; ++r) { const int orow = crow(r, hi);
#pragma unroll
        for (int d0 = 0; d0 < 4; ++d0) stg[orow * 128 + d0 * 32 + r32] = __float2bfloat16(o[d0][r] * rli[r]); }
    asm volatile("s_waitcnt lgkmcnt(0)" ::: "memory");
    { const int l3 = opaque(lane); const unsigned vo = (unsigned)((wid * QBLK + (l3 >> 4)) * 1024 + (l3 & 15) * 8) * 2u;
#pragma unroll
    for (int i = 0; i < 8; ++i) { const int row = i * 4 + (l3 >> 4), ch = l3 & 15;
        const u32x4 ov = *(const u32x4*)(stg + row * 128 + ch * 8);
        const u32x4 gv = __builtin_amdgcn_raw_buffer_load_b128(rs, vo, cur.o + (unsigned)(i * 4 * 1024 * 2), 0);
        u32x4 w;
#pragma unroll
        for (int j = 0; j < 4; ++j) { const float olo = __uint_as_float(ov[j] << 16), ohi = __uint_as_float(ov[j] & 0xffff0000u), glo = __uint_as_float(gv[j] << 16), ghi = __uint_as_float(gv[j] & 0xffff0000u);
            w[j] = cvtpk(olo * glo, ohi * ghi); }
        __builtin_amdgcn_raw_buffer_store_b128(w, rs, vo, cur.o + (unsigned)(i * 4 * 1024 * 2), 0); } }
    asm volatile("s_waitcnt lgkmcnt(0)" ::: "memory"); QPWRITE();
    __syncthreads();
#undef RESC
#undef KBASE
#undef MASKT
#undef HALF_STEP
}
#undef VMW
#undef VMWN
#undef SLOAD
#undef QLOAD
#undef QPLOAD
#undef QPWRITE
#undef SWRITE_K
#undef SWRITE_V
#undef SWRITE_ALL
#undef KSWZ
#undef SBAR
}

constexpr int NWAVES = 8;
constexpr int NSTEPS = 16;
constexpr size_t MiB = 1u << 20;
constexpr size_t WS_CTL = 0, CTL_ZERO_BYTES = 64 * 1024;
constexpr size_t WS_SSQ = 1 * MiB, WS_SSQL = 1 * MiB + 256 * 1024;
constexpr size_t WS_W = 2 * MiB;
constexpr size_t SZ_WINM = (size_t)ZN * 1024 * 2, SZ_WQB = (size_t)QP * Q_LORA * 2, SZ_WKVB = (size_t)KVP * KV_LORA * 2, SZ_WO = (size_t)1024 * 1024 * 2, SZ_WINC = (size_t)CONV_IN * 1024 * 2;
constexpr size_t WS_WINM = WS_W, WS_WQB = WS_WINM + 2 * SZ_WINM, WS_WKVB = WS_WQB + 2 * SZ_WQB, WS_WOM = WS_WKVB + 2 * SZ_WKVB, WS_WINC = WS_WOM + 2 * SZ_WO, WS_WOC = WS_WINC + 2 * SZ_WINC;
static_assert(WS_WOC + 2 * SZ_WO <= 34 * MiB, "weights region");
constexpr size_t WS_COS = 34 * MiB, WS_SIN = 36 * MiB;
constexpr size_t WS_OA = 38 * MiB;
constexpr size_t WS_ZM = 70 * MiB;
constexpr size_t WS_XB = 94 * MiB;
constexpr size_t WS_Q = 126 * MiB, WS_U = 126 * MiB;
constexpr size_t WS_KV = 174 * MiB, WS_G = 174 * MiB;
constexpr size_t WS_END = 238 * MiB;
constexpr int CW_BAR = 1024;
constexpr int RING_OFF = 0, MISC_OFF = 149504, LDS_BYTES = 150 * 1024;
static_assert(attn::LDS_BYTES <= MISC_OFF && pg8::STAGE_BYTES <= MISC_OFF, "LDS map");

#define GAS __attribute__((address_space(1)))
#define LAS __attribute__((address_space(3)))
typedef unsigned short bf16u;
typedef unsigned v4u __attribute__((ext_vector_type(4)));
typedef float f32x4 __attribute__((ext_vector_type(4)));
typedef float f32x2 __attribute__((ext_vector_type(2)));
typedef GAS unsigned gu32;
#define RLX_AGENT __ATOMIC_RELAXED, __HIP_MEMORY_SCOPE_AGENT
#define LDS_WAIT() asm volatile("s_waitcnt lgkmcnt(0)" ::: "memory")
__device__ __forceinline__ unsigned f2bf(float f) { unsigned u = __builtin_bit_cast(unsigned, f); return (u + 0x7fffu + ((u >> 16) & 1u)) >> 16; }
__device__ __forceinline__ unsigned pk2(float lo, float hi) { return f2bf(lo) | (f2bf(hi) << 16); }

#define XB_TMO      128
#define XB_XCNT(j)  (256  + 64 * (j))
#define XB_XSUB(j)  (1280 + 64 * (j))
#define XB_XGEN(j)  (2304 + 64 * (j))
#define XB_TOP      3328
#define XB_TOPGEN   3392
#define XCD_BAR_WORDS 3456
#define XB_SPIN_CAP (1u << 18)
__device__ __forceinline__ unsigned xb_ld(unsigned* p)              { return __hip_atomic_load(p, __ATOMIC_RELAXED, __HIP_MEMORY_SCOPE_AGENT); }
__device__ __forceinline__ unsigned xb_add(unsigned* p, unsigned v) { return __hip_atomic_fetch_add(p, v, __ATOMIC_RELAXED, __HIP_MEMORY_SCOPE_AGENT); }
__device__ __forceinline__ unsigned xb_xcc_id() { return (unsigned)__builtin_amdgcn_s_getreg((3 << 11) | 20) & 0xFu; }
#define XB_SPIN(cond, bar) do { unsigned _sp = 0; while (cond) { __builtin_amdgcn_s_sleep(1); \
    if ((++_sp & 255u) == 0u) { if (xb_ld(&(bar)[XB_TMO])) break; if (_sp > XB_SPIN_CAP) { atomicAdd(&(bar)[XB_TMO], 1u); break; } } } } while (0)
struct XcdBarrier { unsigned* bar; unsigned x; volatile LAS unsigned* st; };
__device__ __forceinline__ XcdBarrier xcd_barrier_post(unsigned* bar, volatile LAS unsigned* st) {
    XcdBarrier b; b.bar = bar; b.x = xb_xcc_id(); b.st = st;
    if (threadIdx.x == 0) (void)xb_add(&bar[XB_XCNT(b.x)], 1u);
    return b;
}
__device__ __forceinline__ void xcd_barrier_complete(unsigned* bar, unsigned x, unsigned& nloc, unsigned& nx) {
    const unsigned G = gridDim.x * gridDim.y * gridDim.z;
    unsigned sum, cnt, mine, sp = 0u;
    for (;;) {
        sum = 0u; cnt = 0u; mine = 0u;
#pragma unroll
        for (unsigned j = 0; j < 16; ++j) { const unsigned c = xb_ld(&bar[XB_XCNT(j)]); sum += c; cnt += (c > 0u) ? 1u : 0u; mine = (j == x) ? c : mine; }
        if (sum == G) break;
        __builtin_amdgcn_s_sleep(1);
        if ((++sp & 255u) == 0u) { if (xb_ld(&bar[XB_TMO])) break; if (sp > XB_SPIN_CAP) { atomicAdd(&bar[XB_TMO], 1u); break; } }
    }
    nloc = mine > 0u ? mine : 1u; nx = cnt > 0u ? cnt : 1u;
}
__device__ __forceinline__ void xcd_barrier(const XcdBarrier& b) {
    asm volatile("s_waitcnt vmcnt(0)" ::: "memory");
    __syncthreads();
    if (threadIdx.x == 0) {
        unsigned* bar = b.bar;
        __builtin_amdgcn_s_waitcnt(0);
        unsigned nloc = b.st[0], nx = b.st[1];
        if (nloc == 0u) { xcd_barrier_complete(bar, b.x, nloc, nx); b.st[0] = nloc; b.st[1] = nx; }
        const unsigned old = xb_add(&bar[XB_XSUB(b.x)], 1u);
        const unsigned gen = old / nloc;
        if (old + 1u == (gen + 1u) * nloc) {
            __builtin_amdgcn_fence(__ATOMIC_RELEASE, "agent");
            asm volatile("s_waitcnt vmcnt(0)" ::: "memory");
            const unsigned og = xb_add(&bar[XB_TOP], 1u);
            const unsigned tg = og / nx;
            if (og + 1u == (tg + 1u) * nx) xb_add(&bar[XB_TOPGEN], 1u);
            else XB_SPIN(xb_ld(&bar[XB_TOPGEN]) == tg, bar);
            __builtin_amdgcn_fence(__ATOMIC_ACQUIRE, "agent");
            xb_add(&bar[XB_XGEN(b.x)], 1u);
            asm volatile("s_waitcnt vmcnt(0)" ::: "memory");
        } else {
            XB_SPIN(xb_ld(&bar[XB_XGEN(b.x)]) == gen, bar);
            __builtin_amdgcn_fence(__ATOMIC_ACQUIRE, "agent");
            asm volatile("s_waitcnt vmcnt(0)" ::: "memory");
        }
    }
    __syncthreads();
}

__device__ __forceinline__ float wave_sum(float v) {
#pragma unroll
    for (int o = 1; o < 64; o <<= 1) v += __shfl_xor(v, o);
    return v;
}

template <int MAP> __device__ __forceinline__ int dst_row(int n) {
    if (MAP == 1) {
        if (n < 384) return n;
        if (n < 640) return Z_KV + (n - 384);
        if (n < 704) { const int j = n - 640; return Z_KPE + (j < 32 ? 2 * j : 2 * (j - 32) + 1); }
        return Z_GATE + (n - 704);
    }
    if (MAP == 2) {
        const int h = n / 192, d = n % 192; if (d < 128) return n; const int j = d - 128; return h * 192 + 128 + (j < 32 ? 2 * j : 2 * (j - 32) + 1);
    }
    if (MAP == 3) {
        if (n < 2048) { const int c = n & 1023, isb = n >> 10; return 256 * (c >> 7) + 2 * (c & 127) + isb; }
        return n;
    }
    return n;
}
template <int MAP>
__device__ __forceinline__ void p0_transpose_item(const float* W, int K, int N, bf16u* WT, const float* gain, LAS float* scr, int item, int lane) {
    const int nblk = N / 32, kb = item / nblk, nb = item % nblk, k0 = 64 * kb, n0 = 32 * nb;
    float wv[32];
#pragma unroll
    for (int i = 0; i < 32; ++i) { const int kk = 2 * i + (lane >> 5); wv[i] = W[(size_t)(k0 + kk) * N + n0 + (lane & 31)]; }
#pragma unroll
    for (int i = 0; i < 32; ++i) { const int kk = 2 * i + (lane >> 5); const float gk = gain ? gain[k0 + kk] : 1.f; scr[kk * 33 + (lane & 31)] = wv[i] * gk; }
    LDS_WAIT(); asm volatile("" ::: "memory");
    const int c = lane & 7;
#pragma unroll
    for (int j = 0; j < 4; ++j) { const int n = (lane >> 3) + 8 * j; const LAS float* s = scr + (8 * c) * 33 + n;
        v4u o; o.x = pk2(s[0 * 33], s[1 * 33]); o.y = pk2(s[2 * 33], s[3 * 33]); o.z = pk2(s[4 * 33], s[5 * 33]); o.w = pk2(s[6 * 33], s[7 * 33]);
        *(GAS v4u*)(WT + (size_t)dst_row<MAP>(n0 + n) * K + k0 + 8 * c) = o; }
    LDS_WAIT(); asm volatile("" ::: "memory");
}

__constant__ float c_inv_freq[32] = {
    1.0f, 0.7498942093324559f, 0.5623413251903491f, 0.4216965034285822f, 0.31622776601683794f, 0.23713737056616552f, 0.1778279410038923f, 0.1333521432163324f,
    0.1f, 0.07498942093324558f, 0.05623413251903491f, 0.04216965034285822f, 0.03162277660168379f, 0.023713737056616554f, 0.01778279410038923f, 0.01333521432163324f,
    0.01f, 0.007498942093324558f, 0.005623413251903491f, 0.004216965034285823f, 0.0031622776601683794f, 0.0023713737056616554f, 0.0017782794100389228f, 0.001333521432163324f,
    0.001f, 0.0007498942093324559f, 0.0005623413251903491f, 0.00042169650342858224f, 0.00031622776601683794f, 0.00023713737056616554f, 0.00017782794100389227f, 0.0001333521432163324f };


#ifndef PROBE_KIND
#define PROBE_KIND -1
#endif
struct Args { const void* in[19]; float* out; unsigned char* ws; int lo, hi; };
typedef __amdgpu_buffer_rsrc_t rsrc_t;

#define DPP_ADD(v, ctrl, rmask) v += __builtin_bit_cast(float, __builtin_amdgcn_update_dpp(0, __builtin_bit_cast(int, v), ctrl, rmask, 0xF, false))
__device__ __forceinline__ float wave_sum_to_lane63(float v) {
    DPP_ADD(v, 0xB1, 0xF); DPP_ADD(v, 0x4E, 0xF); DPP_ADD(v, 0x141, 0xF); DPP_ADD(v, 0x140, 0xF); DPP_ADD(v, 0x142, 0xA); DPP_ADD(v, 0x143, 0xC);
    return v;
}
#undef DPP_ADD
__device__ __forceinline__ void conv_phase(rsrc_t rs, const float* dw_w, const float* dw_b, const float* ln_g, const float* ln_b, int vcu, int G, LAS unsigned char* lds) {
    const int tid = pg8::opaque((int)threadIdx.x), lane = tid & 63, wid = __builtin_amdgcn_readfirstlane(tid >> 6);
    const int c = 2 * tid; const unsigned vo = (unsigned)tid * 4u;
    const rsrc_t rw = __builtin_amdgcn_make_buffer_rsrc((void*)dw_w, 0, CONV_K * 1024 * 4, 0x00020000);
    float w0[CONV_K], w1[CONV_K];
#pragma unroll
    for (int k = 0; k < CONV_K; ++k) { const f32x2 w = __builtin_bit_cast(f32x2, __builtin_amdgcn_raw_buffer_load_b64(rw, vo * 2u, (unsigned)(k * 4096), 0)); w0[k] = w.x; w1[k] = w.y; }
    const f32x2 db = *(const f32x2*)(dw_b + c), lg = *(const f32x2*)(ln_g + c), lb = *(const f32x2*)(ln_b + c);
    LAS float* red = (LAS float*)lds;
    LAS float* stat = (LAS float*)(lds + 4096);
#define SOFF(base_, row_) ((unsigned)__builtin_amdgcn_readfirstlane((int)((unsigned)(base_) + (unsigned)(row_) * 2048u)))
    for (int tile = vcu; tile < MTOK / 32; tile += G) {
        const int b = tile >> 6, t0 = (tile & 63) * 32; const unsigned rowbase = (unsigned)b * SEQ;
#define CONV_LD(r_) __builtin_amdgcn_raw_buffer_load_b32(rs, vo, SOFF(WS_U, rowbase + (unsigned)((t0 - 30 + (r_)) < 0 ? 0 : (t0 - 30 + (r_)))), 0)
        float a0[32], a1[32];
#pragma unroll
        for (int t = 0; t < 32; ++t) { a0[t] = 0.f; a1[t] = 0.f; }
        unsigned ucur[8], unxt[8];
#pragma unroll
        for (int i = 0; i < 8; ++i) ucur[i] = CONV_LD(i);
#pragma unroll
        for (int g = 0; g < 8; ++g) {
#pragma unroll
            for (int i = 0; i < 8; ++i) { const int r = (g + 1) * 8 + i; unxt[i] = (r < 62) ? CONV_LD(r) : 0u; }
            asm volatile("" ::: "memory"); __builtin_amdgcn_sched_barrier(0);
#pragma unroll
            for (int i = 0; i < 8; ++i) { const int r = g * 8 + i;
                if (r < 62) { const unsigned uv = (t0 - 30 + r < 0) ? 0u : ucur[i];
                    const float u0 = __uint_as_float(uv << 16), u1 = __uint_as_float(uv & 0xffff0000u);
#pragma unroll
                    for (int t = 0; t < 32; ++t) { const int k = r - t; if (k >= 0 && k < CONV_K) { a0[t] = fmaf(w0[k], u0, a0[t]); a1[t] = fmaf(w1[k], u1, a1[t]); } } } }
#pragma unroll
            for (int i = 0; i < 8; ++i) ucur[i] = unxt[i];
        }
#undef CONV_LD
        __builtin_amdgcn_sched_barrier(0);
        unsigned gv[32];
#pragma unroll
        for (int t = 0; t < 32; ++t) gv[t] = __builtin_amdgcn_raw_buffer_load_b32(rs, vo, SOFF(WS_G, rowbase + (unsigned)(t0 + t)), 0);
        asm volatile("" ::: "memory"); __builtin_amdgcn_sched_barrier(0);
#pragma unroll
        for (int t = 0; t < 32; ++t) {
            a0[t] += db.x; a1[t] += db.y;
            const float s1 = wave_sum_to_lane63(a0[t] + a1[t]), s2 = wave_sum_to_lane63(a0[t] * a0[t] + a1[t] * a1[t]);
            if (lane == 63) *(LAS f32x2*)(red + (t * 8 + wid) * 2) = (f32x2){s1, s2};
            if ((t & 3) == 3) __builtin_amdgcn_sched_barrier(0);
        }
        LDS_WAIT(); __syncthreads();
        if (tid < 32) { float s1 = 0.f, s2 = 0.f;
#pragma unroll
            for (int w = 0; w < 8; ++w) { const f32x2 p = *(const LAS f32x2*)(red + (tid * 8 + w) * 2); s1 += p.x; s2 += p.y; }
            const float mean = s1 * (1.f / 1024.f), var = s2 * (1.f / 1024.f) - mean * mean;
            *(LAS f32x2*)(stat + tid * 2) = (f32x2){mean, rsqrtf(var + LN_EPS)}; }
        LDS_WAIT(); __syncthreads();
#pragma unroll
        for (int t = 0; t < 32; ++t) {
            const f32x2 st = *(const LAS f32x2*)(stat + t * 2);
            const float y0 = (a0[t] - st.x) * st.y * lg.x + lb.x, y1 = (a1[t] - st.x) * st.y * lg.y + lb.y;
            const float o0 = pg8::silu_f(y0) * __uint_as_float(gv[t] << 16), o1 = pg8::silu_f(y1) * __uint_as_float(gv[t] & 0xffff0000u);
            __builtin_amdgcn_raw_buffer_store_b32(pg8::cvt_pk_bf16(o0, o1), rs, vo, SOFF(WS_OA, rowbase + (unsigned)(t0 + t)), 0);
            if ((t & 7) == 7) __builtin_amdgcn_sched_barrier(0);
        }
        LDS_WAIT(); __syncthreads();
    }
#undef SOFF
}

__device__ __forceinline__ attn::BlockRef attn_mkref(int Lq, int pass) {
    const int bh = Lq >> 2, xq = Lq & 3, b = bh >> 3, h = bh & 7, qb = pass ? 7 - xq : xq;
    const unsigned r0 = (unsigned)b * SEQ, rq = r0 + (unsigned)qb * 256;
    attn::BlockRef R;
    R.q = (unsigned)WS_Q + (rq * QP + h * 192) * 2u; R.kn = (unsigned)WS_KV + (r0 * KVP + h * 256) * 2u;
    R.kp = (unsigned)WS_ZM + (r0 * ZP + Z_KPE) * 2u; R.o = (unsigned)WS_OA + (rq * 1024 + h * 128) * 2u; R.P0 = qb * 256;
    return R;
}

enum { K_PRO = 0, K_MIN = 1, K_Q = 2, K_KV = 3, K_ATT = 4, K_OUT = 5, K_CIN = 6, K_CMID = 7, K_FIN = 8 };
template <int KIND>
__device__ __forceinline__ void phase(const Args& args, int j, bool last_out, bool is_conv, unsigned char* lds, bool dup = false) {
    LAS unsigned char* L = (LAS unsigned char*)lds;
    const int tid = pg8::opaque((int)threadIdx.x), lane = tid & 63, wave = __builtin_amdgcn_readfirstlane(tid >> 6);
    int G = gridDim.x, bx = blockIdx.x; unsigned char* ws = args.ws;
    asm volatile("" : "+s"(G), "+s"(bx), "+s"(ws));
    const int vcu = (G % 8 == 0) ? (bx % 8) * (G / 8) + bx / 8 : bx;
    const int gw = vcu * NWAVES + wave, NGW = G * NWAVES;
    float* SSQ = (float*)(ws + WS_SSQ); float* SSQL = (float*)(ws + WS_SSQL);
    float* COS = (float*)(ws + WS_COS); float* SIN = (float*)(ws + WS_SIN);
    if constexpr (KIND == K_PRO) {
        const float* x_in = (const float*)args.in[0]; bf16u* XB = (bf16u*)(ws + WS_XB);
        LAS float* scr = (LAS float*)(L + RING_OFF + wave * 16384);
        constexpr int I_MIN = 16 * (MLA_IN / 32), I_QB = 6 * (QP / 32), I_KVB = 4 * (KVP / 32), I_O = 16 * 32, I_CIN = 16 * (CONV_IN / 32);
        constexpr int PER = I_MIN + I_QB + I_KVB + I_O + I_CIN + I_O;
        for (int it = gw; it < 2 * PER; it += NGW) {
            const int jj = it / PER; int r = it % PER;
            if (r < I_MIN) { p0_transpose_item<1>((const float*)args.in[4] + (size_t)jj * 1024 * MLA_IN, 1024, MLA_IN, (bf16u*)(ws + WS_WINM + jj * SZ_WINM), (const float*)args.in[3] + jj * 1024, scr, r, lane); continue; } r -= I_MIN;
            if (r < I_QB) { p0_transpose_item<2>((const float*)args.in[6] + (size_t)jj * Q_LORA * QP, Q_LORA, QP, (bf16u*)(ws + WS_WQB + jj * SZ_WQB), (const float*)args.in[5] + jj * Q_LORA, scr, r, lane); continue; } r -= I_QB;
            if (r < I_KVB) { p0_transpose_item<0>((const float*)args.in[8] + (size_t)jj * KV_LORA * KVP, KV_LORA, KVP, (bf16u*)(ws + WS_WKVB + jj * SZ_WKVB), (const float*)args.in[7] + jj * KV_LORA, scr, r, lane); continue; } r -= I_KVB;
            if (r < I_O) { p0_transpose_item<0>((const float*)args.in[9] + (size_t)jj * 1024 * 1024, 1024, 1024, (bf16u*)(ws + WS_WOM + jj * SZ_WO), nullptr, scr, r, lane); continue; } r -= I_O;
            if (r < I_CIN) { p0_transpose_item<3>((const float*)args.in[11] + (size_t)jj * 1024 * CONV_IN, 1024, CONV_IN, (bf16u*)(ws + WS_WINC + jj * SZ_WINC), (const float*)args.in[10] + jj * 1024, scr, r, lane); continue; } r -= I_CIN;
            p0_transpose_item<0>((const float*)args.in[17] + (size_t)jj * 1024 * 1024, 1024, 1024, (bf16u*)(ws + WS_WOC + jj * SZ_WO), nullptr, scr, r, lane);
        }
        for (int i = gw * 64 + lane; i < 2 * 64 * 128; i += NGW * 64) { const int jj = i / (64 * 128), rr = (i / 128) % 64, cc = i % 128;
            unsigned z = 0u; asm volatile("" : "+v"(z));
            *(GAS v4u*)(ws + WS_WINM + jj * SZ_WINM + (size_t)(448 + rr) * 2048 + cc * 16) = (v4u){z, z, z, z}; }
        for (int m0 = gw * 4; m0 < MTOK; m0 += NGW * 4) {
            f32x4 v[4][4]; float ss[4];
#pragma unroll
            for (int i = 0; i < 4; ++i) { const GAS f32x4* xr = (const GAS f32x4*)(x_in + (size_t)(m0 + i) * 1024) + lane;
#pragma unroll
                for (int q = 0; q < 4; ++q) v[i][q] = xr[64 * q]; }
#pragma unroll
            for (int i = 0; i < 4; ++i) { float s_ = 0.f;
#pragma unroll
                for (int q = 0; q < 4; ++q) s_ += (v[i][q].x * v[i][q].x + v[i][q].y * v[i][q].y) + (v[i][q].z * v[i][q].z + v[i][q].w * v[i][q].w);
                ss[i] = wave_sum(s_); }
#pragma unroll
            for (int i = 0; i < 4; ++i) { GAS unsigned long long* o8 = (GAS unsigned long long*)(XB + (size_t)(m0 + i) * 1024) + lane;
#pragma unroll
                for (int q = 0; q < 4; ++q) o8[64 * q] = (unsigned long long)pk2(v[i][q].x, v[i][q].y) | ((unsigned long long)pk2(v[i][q].z, v[i][q].w) << 32);
                if (lane == 0) *(f32x4*)(SSQ + (size_t)(m0 + i) * 4) = (f32x4){ss[i], 0.f, 0.f, 0.f}; }
        }
        const int* pos = (const int*)args.in[1];
        for (int i = gw * 64 + lane; i < MTOK * 32; i += NGW * 64) {
            const int m = i >> 5, fi = i & 31;
            const float ang = (float)pos[m] * c_inv_freq[fi];
            const double rev = (double)ang * 0.15915494309189535; const float fr = (float)(rev - __builtin_rint(rev));
            COS[i] = __builtin_amdgcn_cosf(fr); SIN[i] = __builtin_amdgcn_sinf(fr);
        }
    }
    if constexpr (KIND == K_FIN) {
        const float* gfin = (const float*)args.in[2]; float* xs = args.out; float* xo = dup ? (float*)(ws + WS_KV) : args.out;
        for (int m = gw; m < MTOK; m += NGW) {
            const f32x4 sx = *(const f32x4*)(SSQ + (size_t)m * 4);
            const float rstd = rsqrtf(((sx[0] + sx[1]) + (sx[2] + sx[3])) * (1.0f / 1024.0f) + RMS_EPS);
            GAS f32x4* xr = (GAS f32x4*)(xs + (size_t)m * 1024) + lane; GAS f32x4* xw = (GAS f32x4*)(xo + (size_t)m * 1024) + lane;
#pragma unroll
            for (int q = 0; q < 4; ++q) { const f32x4 g4 = *((const f32x4*)gfin + lane + 64 * q); f32x4 v = xr[64 * q]; v = v * rstd * g4; xw[64 * q] = v; }
        }
    }
    if constexpr (KIND == K_MIN) {
        pg8::Gemm g{(const bf16u*)(ws + WS_XB), (const bf16u*)(ws + WS_WINM + j * SZ_WINM), MTOK, ZN, 1024, 1024}; pg8::StaticOrder S; S.init(MTOK, ZN, G, bx);
        pg8::EpiMlaIn E{(bf16u*)(ws + WS_ZM), (bf16u*)(ws + WS_OA), SSQ, SSQL, COS, SIN};
        pg8::gemm_phase<pg8::EpiMlaIn, pg8::StaticOrder, true, true>(L + RING_OFF, g, S, E);
    }
    if constexpr (KIND == K_Q) {
        pg8::Gemm g{(const bf16u*)(ws + WS_ZM), (const bf16u*)(ws + WS_WQB + j * SZ_WQB), MTOK, QP, Q_LORA, ZP}; pg8::StaticOrder S; S.init(MTOK, QP, G, bx);
        pg8::EpiQ E{(bf16u*)(ws + WS_Q), SSQL, COS, SIN};
        pg8::gemm_phase<pg8::EpiQ, pg8::StaticOrder, true, true>(L + RING_OFF, g, S, E);
    }
    if constexpr (KIND == K_KV) {
        pg8::Gemm g{(const bf16u*)(ws + WS_ZM) + Z_KV, (const bf16u*)(ws + WS_WKVB + j * SZ_WKVB), MTOK, KVP, KV_LORA, ZP}; pg8::StaticOrder S; S.init(MTOK, KVP, G, bx);
        pg8::EpiKV E{(bf16u*)(ws + WS_KV), SSQL};
        pg8::gemm_phase<pg8::EpiKV, pg8::StaticOrder, true, true>(L + RING_OFF, g, S, E);
    }
    if constexpr (KIND == K_ATT) {
        const rsrc_t rs = __builtin_amdgcn_make_buffer_rsrc((void*)ws, 0, (unsigned)WS_END, 0x00020000);
        attn::Seam SM; bool primed = false;
        attn::BlockRef cur{};
        for (int Lq = vcu; Lq < 256; Lq += G) {
            for (int pass = 0; pass < 2; ++pass) {
                if (!primed) { cur = attn_mkref(Lq, pass); attn::attn_prime(cur, rs, (char*)lds, SM); primed = true; }
                const bool last = (pass == 1) && (Lq + G >= 256);
                const attn::BlockRef nxt = last ? cur : (pass == 0 ? attn_mkref(Lq, 1) : attn_mkref(Lq + G, 0));
                attn::attn_block(cur, nxt, rs, (char*)lds, SM);
                cur = nxt;
            }
        }
        asm volatile("s_waitcnt vmcnt(0)" ::: "memory"); __syncthreads();
    }
    if constexpr (KIND == K_OUT) {
        const bf16u* Wt = (const bf16u*)(ws + (is_conv ? WS_WOC : WS_WOM) + j * SZ_WO);
        pg8::Gemm g{(const bf16u*)(ws + WS_OA), Wt, MTOK, 1024, 1024, 1024}; pg8::StaticOrder S; S.init(MTOK, 1024, G, bx);
        pg8::EpiResid E{(const bf16u*)(ws + WS_XB), (bf16u*)(ws + (dup ? WS_KV : WS_XB)), (last_out && !dup) ? args.out : nullptr, dup ? SSQL : SSQ, is_conv ? (const float*)args.in[18] + j * 1024 : nullptr};
        pg8::gemm_phase<pg8::EpiResid, pg8::StaticOrder, false, true>(L + RING_OFF, g, S, E);
    }
    if constexpr (KIND == K_CIN) {
        pg8::Gemm g{(const bf16u*)(ws + WS_XB), (const bf16u*)(ws + WS_WINC + j * SZ_WINC), MTOK, CONV_IN, 1024, 1024}; pg8::StaticOrder S; S.init(MTOK, CONV_IN, G, bx);
        pg8::EpiConvIn E{(bf16u*)(ws + WS_U), (bf16u*)(ws + WS_G), SSQ, (const float*)args.in[12] + j * CONV_IN};
        pg8::gemm_phase<pg8::EpiConvIn, pg8::StaticOrder, true, true>(L + RING_OFF, g, S, E);
    }
    if constexpr (KIND == K_CMID) {
        const rsrc_t rs = __builtin_amdgcn_make_buffer_rsrc((void*)ws, 0, (unsigned)WS_END, 0x00020000);
        conv_phase(rs, (const float*)args.in[13] + j * CONV_K * 1024, (const float*)args.in[14] + j * 1024, (const float*)args.in[15] + j * 1024, (const float*)args.in[16] + j * 1024, vcu, G, L + RING_OFF);
    }
}

#if MK_STEPWISE
template <int KIND>
__global__ void __launch_bounds__(NWAVES * 64, 2) step_kernel(Args args) {
    extern __shared__ __attribute__((aligned(16))) unsigned char lds[];
    const int s = args.lo, r7 = (s - 1) % 7, j = (s - 1) / 7;
    phase<KIND>(args, j, s == NSTEPS - 2, r7 == 6, lds);
}
template <int KIND> static void launch_step(Args a, int s, int grid, hipStream_t stream) {
    static bool done = false;
    if (!done) { done = true; (void)hipFuncSetAttribute((const void*)step_kernel<KIND>, hipFuncAttributeMaxDynamicSharedMemorySize, LDS_BYTES); }
    a.lo = s; a.hi = s + 1;
    hipLaunchKernelGGL(step_kernel<KIND>, dim3(grid), dim3(NWAVES * 64), LDS_BYTES, stream, a);
}
#else
__global__ void __launch_bounds__(NWAVES * 64, 2) trunk_fwd(Args args) {
    extern __shared__ __attribute__((aligned(16))) unsigned char lds[];
    volatile LAS unsigned* MISC = (volatile LAS unsigned*)((LAS unsigned char*)lds + MISC_OFF);
    if (threadIdx.x < 32) MISC[threadIdx.x] = 0u;
    __syncthreads();
    XcdBarrier bar = xcd_barrier_post((unsigned*)(args.ws + WS_CTL) + CW_BAR, MISC + 8);
    for (int s = args.lo; s < args.hi; ++s) {
        const int r7 = (s - 1) % 7, j = (s - 1) / 7;
#define RUNP(K, ...) do { if (PROBE_KIND == (K)) { phase<K>(__VA_ARGS__, true); } phase<K>(__VA_ARGS__); } while (0)
        if (s == 0) RUNP(K_PRO, args, 0, false, false, lds);
        else if (s == NSTEPS - 1) RUNP(K_FIN, args, 0, false, false, lds);
        else if (r7 == 0) RUNP(K_MIN, args, j, false, false, lds);
        else if (r7 == 1) { RUNP(K_Q, args, j, false, false, lds); RUNP(K_KV, args, j, false, false, lds); }
        else if (r7 == 2) RUNP(K_ATT, args, j, false, false, lds);
        else if (r7 == 3 || r7 == 6) RUNP(K_OUT, args, j, s == NSTEPS - 2, r7 == 6, lds);
        else if (r7 == 4) RUNP(K_CIN, args, j, false, false, lds);
        else RUNP(K_CMID, args, j, false, false, lds);
#undef RUNP
        if (s + 1 < args.hi) { xcd_barrier(bar); if (PROBE_KIND == 9) xcd_barrier(bar); }
    }
}
#endif

extern "C" void kernel_launch(void* const* d_in, const int* in_sizes, int n_in, void* d_out, int out_size, void* d_ws, size_t ws_size, hipStream_t stream) {
    static int grid = 0;
    if (grid == 0) {
        if (n_in != 19 || in_sizes[0] != MTOK * D_MODEL || out_size != MTOK * D_MODEL || ws_size < WS_END) {
            fprintf(stderr, "kernel_launch: unexpected shapes (n_in %d, in0 %d, out %d, ws %zu); nothing launched\n", n_in, n_in > 0 ? in_sizes[0] : -1, out_size, ws_size); grid = -1; return; }
        int dev = 0, cus = 0;
        if (hipGetDevice(&dev) != hipSuccess || hipDeviceGetAttribute(&cus, hipDeviceAttributeMultiprocessorCount, dev) != hipSuccess) { grid = -1; return; }
#if !MK_STEPWISE
        int per_cu = 0;
        if (hipFuncSetAttribute((const void*)trunk_fwd, hipFuncAttributeMaxDynamicSharedMemorySize, LDS_BYTES) != hipSuccess) { fprintf(stderr, "kernel_launch: hipFuncSetAttribute failed\n"); grid = -1; return; }
        if (hipOccupancyMaxActiveBlocksPerMultiprocessor(&per_cu, (const void*)trunk_fwd, NWAVES * 64, LDS_BYTES) != hipSuccess || per_cu < 1) { fprintf(stderr, "kernel_launch: occupancy query says %d blocks per CU\n", per_cu); (void)hipGetLastError(); }
#endif
        grid = cus;
    }
    if (grid < 0) return;
    Args a{};
    for (int i = 0; i < 19; ++i) a.in[i] = d_in[i];
    a.out = (float*)d_out; a.ws = (unsigned char*)d_ws;
#if MK_STEPWISE
    for (int s = 0; s < NSTEPS; ++s) {
        const int r7 = (s - 1) % 7;
        if (s == 0) launch_step<K_PRO>(a, s, grid, stream);
        else if (s == NSTEPS - 1) launch_step<K_FIN>(a, s, grid, stream);
        else if (r7 == 0) launch_step<K_MIN>(a, s, grid, stream);
        else if (r7 == 1) { launch_step<K_Q>(a, s, grid, stream); launch_step<K_KV>(a, s, grid, stream); }
        else if (r7 == 2) launch_step<K_ATT>(a, s, grid, stream);
        else if (r7 == 3 || r7 == 6) launch_step<K_OUT>(a, s, grid, stream);
        else if (r7 == 4) launch_step<K_CIN>(a, s, grid, stream);
        else launch_step<K_CMID>(a, s, grid, stream);
    }
#else
    if (hipMemsetAsync((char*)d_ws + WS_CTL, 0, CTL_ZERO_BYTES, stream) != hipSuccess) return;
    a.lo = 0; a.hi = NSTEPS;
    void* kargs[] = {&a};
    hipError_t e = hipLaunchCooperativeKernel((const void*)trunk_fwd, dim3(grid), dim3(NWAVES * 64), kargs, LDS_BYTES, stream);
    if (e != hipSuccess) fprintf(stderr, "kernel_launch: cooperative launch failed: %s (grid %d)\n", hipGetErrorString(e), grid);
#endif
}
```

```cpp
#include <hip/hip_runtime.h>
#include <hip/hip_bf16.h>
#include <cstdio>
#include <cstdint>

#ifndef MK_STEPWISE
#define MK_STEPWISE 0
#endif

constexpr int D_MODEL = 1024, BATCH = 8, SEQ = 2048, MTOK = BATCH * SEQ;
constexpr int N_HEADS = 8, QK_NOPE = 128, QK_ROPE = 64, V_HEAD = 128, Q_LORA = 384, KV_LORA = 256;
constexpr int MLA_IN = Q_LORA + KV_LORA + QK_ROPE + N_HEADS * V_HEAD;
constexpr int ZN = 1792;
constexpr int ZP = 768;
constexpr int Z_KPE = 384, Z_KV = 512, Z_GATE = 768;
constexpr int QP = N_HEADS * (QK_NOPE + QK_ROPE);
constexpr int KVP = N_HEADS * (QK_NOPE + V_HEAD);
constexpr int CONV_K = 31, CONV_IN = 3 * D_MODEL;
constexpr float RMS_EPS = 1e-6f, LN_EPS = 1e-5f;

namespace pg8 {
#define PG8_LAS __attribute__((address_space(3)))
typedef unsigned short bf16_t;
typedef short bf16x8 __attribute__((ext_vector_type(8)));
typedef float f32x4 __attribute__((ext_vector_type(4)));
typedef unsigned u32x4 __attribute__((ext_vector_type(4)));
typedef unsigned u32x2 __attribute__((ext_vector_type(2)));
constexpr int BM = 256, BK = 64, HALF = 128, HTB = HALF * BK * 2  , STAGE_BYTES = 8 * HTB, NXCD = 8, WGM = 8;

__host__ __device__ __forceinline__ int lds_byte(int r, int c) { const int st = (r >> 4) * 2 + (c >> 5), rr = r & 15, cc = c & 31, ob = rr * 64 + cc * 2; return st * 1024 + (ob ^ (((ob >> 9) & 1) << 5)); }
__host__ __device__ __forceinline__ void stage_rc(int b, int& R, int& C) { const int st = b / 1024, sb = b % 1024, swz = sb ^ (((sb >> 9) & 1) << 5); R = (st >> 1) * 16 + swz / 64; C = (st & 1) * 32 + (swz % 64) / 2; }
__host__ __device__ __forceinline__ int perm32(int rho) { const int n = rho >> 4, i = rho & 15; return 8 * (i >> 2) + 4 * n + (i & 3); }

struct Unit { int pm, pn; };
struct Gemm { const bf16_t* A; const bf16_t* Bt; int M, N, K, lda; };

struct StaticOrder {
    int nM, nN, nwg, G, c;
    __host__ __device__ void init(int M, int N, int G_, int c_) { nM = M / BM; nN = N / BM; nwg = nM * nN; G = G_; c = c_; }
    __host__ __device__ bool next(int i, Unit& u) const {
        const long L = (long)i * G + c; if (L >= nwg) return false;
        int wgid = (int)L; { const int q = nwg / NXCD, r = nwg % NXCD, xcd = wgid % NXCD, off = wgid / NXCD; wgid = (xcd < r ? xcd * (q + 1) : r * (q + 1) + (xcd - r) * q) + off; }
        const int nig = WGM * nN, gid = wgid / nig, fm = gid * WGM, gsz = (nM - fm) < WGM ? (nM - fm) : WGM;
        u.pm = fm + ((wgid % nig) % gsz); u.pn = (wgid % nig) / gsz; return true;
    }
    __device__ __forceinline__ void a_ready(const Unit&) const {}
    __device__ __forceinline__ void done(const Unit&) const {}
};

__device__ __forceinline__ unsigned cvt_pk_bf16(float lo, float hi) { unsigned r; asm volatile("v_cvt_pk_bf16_f32 %0, %1, %2" : "=v"(r) : "v"(lo), "v"(hi)); return r; }
__device__ __forceinline__ int opaque(int x) { asm volatile("" : "+v"(x)); return x; }
__device__ __forceinline__ float sigmoid_f(float v) { return __builtin_amdgcn_rcpf(1.f + __builtin_amdgcn_exp2f(-1.4426950408889634f * v)); }
__device__ __forceinline__ float silu_f(float v) { return v * sigmoid_f(v); }
__device__ __forceinline__ u32x4 pack8(const f32x4& a, const f32x4& b) { u32x4 w; w.x = cvt_pk_bf16(a[0], a[1]); w.y = cvt_pk_bf16(a[2], a[3]); w.z = cvt_pk_bf16(b[0], b[1]); w.w = cvt_pk_bf16(b[2], b[3]); return w; }
__device__ __forceinline__ float sumsq8(const f32x4& a, const f32x4& b) { return ((a[0] * a[0] + a[1] * a[1]) + (a[2] * a[2] + a[3] * a[3])) + ((b[0] * b[0] + b[1] * b[1]) + (b[2] * b[2] + b[3] * b[3])); }
__device__ __forceinline__ void rope8(f32x4& v0, f32x4& v1, const float* cs, const float* sn, size_t grow, int i0) {
    const f32x4 c = *(const f32x4*)(cs + grow * 32 + i0), s = *(const f32x4*)(sn + grow * 32 + i0);
    const f32x4 a = v0, b = v1;
    v0[0] = a[0] * c[0] - a[1] * s[0]; v0[1] = a[1] * c[0] + a[0] * s[0];
    v0[2] = a[2] * c[1] - a[3] * s[1]; v0[3] = a[3] * c[1] + a[2] * s[1];
    v1[0] = b[0] * c[2] - b[1] * s[2]; v1[1] = b[1] * c[2] + b[0] * s[2];
    v1[2] = b[2] * c[3] - b[3] * s[3]; v1[3] = b[3] * c[3] + b[2] * s[3];
}

template <int NP>
__device__ __forceinline__ void row_rstd8(float (&rstd)[8], const float* ssq, int stride, int off, int row0, float inv_n, float eps) {
    f32x4 p[8][NP / 4];
#pragma unroll
    for (int i = 0; i < 8; ++i)
#pragma unroll
        for (int q = 0; q < NP / 4; ++q) p[i][q] = *(const f32x4*)(ssq + (size_t)(row0 + (i >> 2) * HALF + (i & 3) * 16) * stride + off + 4 * q);
#pragma unroll
    for (int i = 0; i < 8; ++i) { float s = 0.f;
#pragma unroll
        for (int q = 0; q < NP / 4; ++q) s += (p[i][q][0] + p[i][q][1]) + (p[i][q][2] + p[i][q][3]);
        rstd[i] = rsqrtf(s * inv_n + eps); }
}

struct EpiMlaIn {
    static constexpr bool PERM = true, AFTER_DRAIN = false;
    bf16_t* Z; bf16_t* GO; const float* ssqx; float* ssql; const float* cs; const float* sn;
    __device__ __forceinline__ void operator()(const f32x4 (&acc)[2][2][4][2], const Unit& u, int wr, int wc, int fr_, int fq_) const {
        const int lane_ = opaque((int)(threadIdx.x & 63)), fr = lane_ & 15, fq = lane_ >> 4;
        const int pn = u.pn;
        float rs8[8]; row_rstd8<4>(rs8, ssqx, 4, 0, u.pm * BM + wr * 64 + fr, 1.0f / 1024.0f, RMS_EPS);
#pragma unroll
        for (int ai = 0; ai < 2; ++ai)
#pragma unroll
            for (int m = 0; m < 4; ++m) {
                const size_t grow = (size_t)(u.pm * BM + ai * HALF + wr * 64 + m * 16 + fr);
                const float rstd = rs8[ai * 4 + m];
                float s = 0.f;
#pragma unroll
                for (int bj = 0; bj < 2; ++bj) {
                    f32x4 v0 = acc[ai][bj][m][0] * rstd, v1 = acc[ai][bj][m][1] * rstd;
                    const int col0 = pn * BM + bj * HALF + wc * 32 + 8 * fq;
                    bf16_t* dst = Z + grow * ZP + col0;
                    if (pn >= 3) {
#pragma unroll
                        for (int j = 0; j < 4; ++j) { v0[j] = silu_f(v0[j]); v1[j] = silu_f(v1[j]); }
                        *(u32x4*)(GO + grow * 1024 + (col0 - Z_GATE)) = pack8(v0, v1);
                    } else if (pn == 1 && bj == 1) {
                        if (wc < 2) { rope8(v0, v1, cs, sn, grow, 16 * wc + 4 * fq); *(u32x4*)dst = pack8(v0, v1); }
                    } else { s += sumsq8(v0, v1); *(u32x4*)dst = pack8(v0, v1); }
                }
                if (pn <= 2) { s += __shfl_xor(s, 16); s += __shfl_xor(s, 32); if (fq == 0) ssql[grow * 12 + pn * 4 + wc] = s; }
                if (m & 1) asm volatile("" ::: "memory");
            }
    }
};
struct EpiQ {
    static constexpr bool PERM = true, AFTER_DRAIN = false;
    bf16_t* Q; const float* ssql; const float* cs; const float* sn;
    __device__ __forceinline__ void operator()(const f32x4 (&acc)[2][2][4][2], const Unit& u, int wr, int wc, int fr_, int fq_) const {
        const int lane_ = opaque((int)(threadIdx.x & 63)), fr = lane_ & 15, fq = lane_ >> 4;
        float rs8[8]; row_rstd8<8>(rs8, ssql, 12, 0, u.pm * BM + wr * 64 + fr, 1.0f / 384.0f, RMS_EPS);
#pragma unroll
        for (int ai = 0; ai < 2; ++ai)
#pragma unroll
            for (int m = 0; m < 4; ++m) {
                const size_t grow = (size_t)(u.pm * BM + ai * HALF + wr * 64 + m * 16 + fr);
                const float rstd = rs8[ai * 4 + m];
#pragma unroll
                for (int bj = 0; bj < 2; ++bj) {
                    f32x4 v0 = acc[ai][bj][m][0] * rstd, v1 = acc[ai][bj][m][1] * rstd;
                    const int cw = u.pn * BM + bj * HALF + wc * 32, hd = cw % 192, col0 = cw + 8 * fq;
                    if (hd >= 128) rope8(v0, v1, cs, sn, grow, ((hd - 128) >> 1) + 4 * fq);
                    *(u32x4*)(Q + grow * QP + col0) = pack8(v0, v1);
                }
                asm volatile("" ::: "memory");
            }
    }
};
struct EpiKV {
    static constexpr bool PERM = true, AFTER_DRAIN = false;
    bf16_t* KV; const float* ssql;
    __device__ __forceinline__ void operator()(const f32x4 (&acc)[2][2][4][2], const Unit& u, int wr, int wc, int fr_, int fq_) const {
        const int lane_ = opaque((int)(threadIdx.x & 63)), fr = lane_ & 15, fq = lane_ >> 4;
        float rs8[8]; row_rstd8<4>(rs8, ssql, 12, 8, u.pm * BM + wr * 64 + fr, 1.0f / 256.0f, RMS_EPS);
#pragma unroll
        for (int ai = 0; ai < 2; ++ai)
#pragma unroll
            for (int m = 0; m < 4; ++m) {
                const size_t grow = (size_t)(u.pm * BM + ai * HALF + wr * 64 + m * 16 + fr);
                const float rstd = rs8[ai * 4 + m];
#pragma unroll
                for (int bj = 0; bj < 2; ++bj) {
                    const f32x4 v0 = acc[ai][bj][m][0] * rstd, v1 = acc[ai][bj][m][1] * rstd;
                    const int col0 = u.pn * BM + bj * HALF + wc * 32 + 8 * fq;
                    *(u32x4*)(KV + grow * KVP + col0) = pack8(v0, v1);
                }
                if (m & 1) asm volatile("" ::: "memory");
            }
    }
};
struct EpiConvIn {
    static constexpr bool PERM = true, AFTER_DRAIN = false;
    bf16_t* U; bf16_t* G; const float* ssqx; const float* bias;
    __device__ __forceinline__ void operator()(const f32x4 (&acc)[2][2][4][2], const Unit& u, int wr, int wc, int fr_, int fq_) const {
        const int lane_ = opaque((int)(threadIdx.x & 63)), fr = lane_ & 15, fq = lane_ >> 4;
        const int pn = u.pn;
        float rs8[8]; row_rstd8<4>(rs8, ssqx, 4, 0, u.pm * BM + wr * 64 + fr, 1.0f / 1024.0f, RMS_EPS);
        f32x4 bA[2], bB[2];
#pragma unroll
        for (int bj = 0; bj < 2; ++bj) {
            if (pn < 8) { const int c0 = pn * 128 + bj * 64 + wc * 16 + 4 * fq; bA[bj] = *(const f32x4*)(bias + c0); bB[bj] = *(const f32x4*)(bias + 1024 + c0); }
            else { const int c0 = (pn - 8) * BM + bj * HALF + wc * 32 + 8 * fq; bA[bj] = *(const f32x4*)(bias + 2048 + c0); bB[bj] = *(const f32x4*)(bias + 2048 + c0 + 4); } }
#pragma unroll
        for (int ai = 0; ai < 2; ++ai)
#pragma unroll
            for (int m = 0; m < 4; ++m) {
                const size_t grow = (size_t)(u.pm * BM + ai * HALF + wr * 64 + m * 16 + fr);
                const float rstd = rs8[ai * 4 + m];
#pragma unroll
                for (int bj = 0; bj < 2; ++bj) {
                    f32x4 v0 = acc[ai][bj][m][0] * rstd, v1 = acc[ai][bj][m][1] * rstd;
                    if (pn < 8) {
                        const int c0 = pn * 128 + bj * 64 + wc * 16 + 4 * fq;
                        const f32x4 ba = bA[bj], bb = bB[bj];
                        const float u0 = (v0[0] + ba[0]) * sigmoid_f(v0[1] + bb[0]), u1 = (v0[2] + ba[1]) * sigmoid_f(v0[3] + bb[1]);
                        const float u2 = (v1[0] + ba[2]) * sigmoid_f(v1[1] + bb[2]), u3 = (v1[2] + ba[3]) * sigmoid_f(v1[3] + bb[3]);
                        u32x2 w; w.x = cvt_pk_bf16(u0, u1); w.y = cvt_pk_bf16(u2, u3);
                        *(u32x2*)(U + grow * 1024 + c0) = w;
                    } else {
                        const int c0 = (pn - 8) * BM + bj * HALF + wc * 32 + 8 * fq;
                        const f32x4 b0 = bA[bj], b1 = bB[bj];
#pragma unroll
                        for (int j = 0; j < 4; ++j) { v0[j] = silu_f(v0[j] + b0[j]); v1[j] = silu_f(v1[j] + b1[j]); }
                        *(u32x4*)(G + grow * 1024 + c0) = pack8(v0, v1);
                    }
                }
                if (m & 1) asm volatile("" ::: "memory");
            }
    }
};
struct EpiResid {
    static constexpr bool PERM = true, AFTER_DRAIN = true;
    const bf16_t* xin; bf16_t* xbo; float* xf32; float* ssq; const float* bias;
    __device__ __forceinline__ void fused(f32x4 (&acc)[2][2][4][2], const Unit& u, int wr, int wc, int fr_, int fq_, PG8_LAS unsigned char* lds, int wid, int lane) const {
        const int lane_ = opaque(lane), fr = lane_ & 15, fq = lane_ >> 4;
        PG8_LAS float* P = (PG8_LAS float*)lds;
        u32x4 xr[2][4][2];
#pragma unroll
        for (int ai = 0; ai < 2; ++ai)
#pragma unroll
            for (int m = 0; m < 4; ++m)
#pragma unroll
                for (int bj = 0; bj < 2; ++bj) xr[ai][m][bj] = *(const u32x4*)(xin + (size_t)(u.pm * BM + ai * HALF + wr * 64 + m * 16 + fr) * 1024 + u.pn * BM + bj * HALF + wc * 32 + 8 * fq);
        asm volatile("" ::: "memory");
#pragma unroll
        for (int ai = 0; ai < 2; ++ai)
#pragma unroll
            for (int m = 0; m < 4; ++m) {
                const int rt = ai * HALF + wr * 64 + m * 16 + fr;
                const size_t grow = (size_t)(u.pm * BM + rt);
                float s = 0.f;
#pragma unroll
                for (int bj = 0; bj < 2; ++bj) {
                    const int col0 = u.pn * BM + bj * HALF + wc * 32 + 8 * fq;
                    const u32x4 xo = xr[ai][m][bj];
                    f32x4 v0 = acc[ai][bj][m][0], v1 = acc[ai][bj][m][1];
                    v0[0] += __uint_as_float(xo[0] << 16); v0[1] += __uint_as_float(xo[0] & 0xffff0000u); v0[2] += __uint_as_float(xo[1] << 16); v0[3] += __uint_as_float(xo[1] & 0xffff0000u);
                    v1[0] += __uint_as_float(xo[2] << 16); v1[1] += __uint_as_float(xo[2] & 0xffff0000u); v1[2] += __uint_as_float(xo[3] << 16); v1[3] += __uint_as_float(xo[3] & 0xffff0000u);
                    if (bias) { v0 += *(const f32x4*)(bias + col0); v1 += *(const f32x4*)(bias + col0 + 4); }
                    if (xf32) { *(f32x4*)(xf32 + grow * 1024 + col0) = v0; *(f32x4*)(xf32 + grow * 1024 + col0 + 4) = v1; }
                    *(u32x4*)(xbo + grow * 1024 + col0) = pack8(v0, v1);
                    s += sumsq8(v0, v1);
                }
                s += __shfl_xor(s, 16); s += __shfl_xor(s, 32);
                if (fq == 0) P[rt * 4 + wc] = s;
                if (m & 1) asm volatile("" ::: "memory");
            }
        asm volatile("s_waitcnt lgkmcnt(0)" ::: "memory"); __builtin_amdgcn_s_barrier(); asm volatile("" ::: "memory");
        const int t = wid * 64 + lane;
        if (t < 256) { const PG8_LAS f32x4* p4 = (const PG8_LAS f32x4*)P; const f32x4 p = p4[t]; ssq[(size_t)(u.pm * BM + t) * 4 + u.pn] = (p[0] + p[1]) + (p[2] + p[3]); }
        asm volatile("s_waitcnt lgkmcnt(0)" ::: "memory"); __builtin_amdgcn_s_barrier(); asm volatile("" ::: "memory");
    }
};

__device__ __forceinline__ f32x4 zero4() { float z = 0.f; asm volatile("" : "+v"(z)); return (f32x4){z, z, z, z}; }
template <class Epi, class Sched, bool ALIGN_EPI = false, bool SP2 = false>
__device__ __forceinline__ void gemm_phase(PG8_LAS unsigned char* lds, const Gemm g, const Sched& S, const Epi& E) {
    const int tid = opaque((int)threadIdx.x), wid = __builtin_amdgcn_readfirstlane(tid >> 6), lane = tid & 63, wr = wid >> 2, wc = wid & 3, fr = lane & 15, fq = lane >> 4;
    const int K = g.K, nt = K / BK, lda = g.lda;
    unsigned voffA[2], voffB[2];
#pragma unroll
    for (int i = 0; i < 2; ++i) { int R, C; stage_rc(tid * 16 + i * 8192, R, C); const int Rb = Epi::PERM ? ((R & ~31) + perm32(R & 31)) : R;
        voffA[i] = (unsigned)(R * lda + C) * 2u; voffB[i] = (unsigned)(Rb * K + C) * 2u; }
    const size_t kstep = (size_t)(BK * 2);
    const size_t hstepA = (size_t)HALF * lda * 2, hstepB = (size_t)HALF * K * 2;
    const size_t tstepA = 2 * hstepA, tstepB = 2 * hstepB;
    const unsigned ldsw = (unsigned)wid * 1024u;
    const int aoff = lds_byte(wr * 64 + fr, fq * 8), boff = lds_byte(wc * 32 + fr, fq * 8);
#define PG8_SA(b, h) (((b) * 2 + (h)) * HTB)
#define PG8_SB(b, h) ((4 + (b) * 2 + (h)) * HTB)
#define PG8_STAGE(bufoff, gbase, voff) do { _Pragma("unroll") for (int _i = 0; _i < 2; ++_i) \
        __builtin_amdgcn_global_load_lds((const unsigned*)((const char*)(gbase) + (voff)[_i]), (PG8_LAS unsigned*)(lds + (bufoff) + ldsw + _i * 8192), 16, 0, 0); } while (0)
#define PG8_LDA(dst, b, h) do { _Pragma("unroll") for (int m = 0; m < 4; ++m) _Pragma("unroll") for (int k = 0; k < 2; ++k) dst[m][k] = *(const PG8_LAS bf16x8*)(lds + PG8_SA(b, h) + aoff + m * 2048 + k * 1024); } while (0)
#define PG8_LDB(dst, b, h) do { _Pragma("unroll") for (int n = 0; n < 2; ++n) _Pragma("unroll") for (int k = 0; k < 2; ++k) dst[n][k] = *(const PG8_LAS bf16x8*)(lds + PG8_SB(b, h) + boff + n * 2048 + k * 1024); } while (0)
#define PG8_MMA(ai, bj, At, Bt) do { __builtin_amdgcn_s_setprio(1); _Pragma("unroll") for (int m = 0; m < 4; ++m) _Pragma("unroll") for (int n = 0; n < 2; ++n) _Pragma("unroll") for (int k = 0; k < 2; ++k) \
        acc[ai][bj][m][n] = __builtin_amdgcn_mfma_f32_16x16x32_bf16(Bt[n][k], At[m][k], acc[ai][bj][m][n], 0, 0, 0); __builtin_amdgcn_s_setprio(0); } while (0)
#define PG8_WAIT_V(n) asm volatile("s_waitcnt vmcnt(" #n ")" ::: "memory")
#define PG8_WAIT_L(n) asm volatile("s_waitcnt lgkmcnt(" #n ")" ::: "memory")
#define PG8_BAR __builtin_amdgcn_s_barrier()
#define PG8_SCHED __builtin_amdgcn_sched_barrier(0)
    Unit cur, nxt; int ui = 0;
    if (!S.next(0, cur)) return;
    f32x4 acc[2][2][4][2];
#pragma unroll
    for (int a = 0; a < 2; ++a)
#pragma unroll
        for (int b = 0; b < 2; ++b)
#pragma unroll
            for (int m = 0; m < 4; ++m)
#pragma unroll
                for (int n = 0; n < 2; ++n) acc[a][b][m][n] = zero4();
    bf16x8 At[4][2] = {}, B0[2][2] = {}, B1[2][2] = {};
    const char* cA = (const char*)g.A + (size_t)cur.pm * tstepA; const char* cB = (const char*)g.Bt + (size_t)cur.pn * tstepB;
    S.a_ready(cur);
    if constexpr (SP2) {
        PG8_STAGE(PG8_SB(0, 0), cB, voffB); PG8_STAGE(PG8_SB(0, 1), cB + hstepB, voffB); PG8_STAGE(PG8_SA(0, 0), cA, voffA); PG8_STAGE(PG8_SA(0, 1), cA + hstepA, voffA);
        if (wr == 1) PG8_BAR;
        PG8_WAIT_V(2); PG8_BAR;
        PG8_STAGE(PG8_SB(1, 0), cB + kstep, voffB); PG8_STAGE(PG8_SA(1, 0), cA + kstep, voffA); PG8_STAGE(PG8_SB(1, 1), cB + hstepB + kstep, voffB);
        PG8_WAIT_V(6); PG8_BAR;
    } else {
        PG8_STAGE(PG8_SB(0, 0), cB, voffB); PG8_STAGE(PG8_SA(0, 0), cA, voffA); PG8_STAGE(PG8_SB(0, 1), cB + hstepB, voffB); PG8_STAGE(PG8_SA(0, 1), cA + hstepA, voffA);
        if (wr == 1) PG8_BAR;
        PG8_WAIT_V(4); PG8_BAR;
        PG8_STAGE(PG8_SB(1, 0), cB + kstep, voffB); PG8_STAGE(PG8_SA(1, 0), cA + kstep, voffA); PG8_STAGE(PG8_SB(1, 1), cB + hstepB + kstep, voffB);
        PG8_WAIT_V(6); PG8_BAR;
    }
    for (;;) {
        const bool has_next = S.next(ui + 1, nxt);
        const char* nA = has_next ? (const char*)g.A + (size_t)nxt.pm * tstepA : cA; const char* nB = has_next ? (const char*)g.Bt + (size_t)nxt.pn * tstepB : cB;
#pragma nounroll
        for (int t = 0; t < nt; t += 2) {
            const bool last = (t == nt - 2);
            const char* a1 = cA + (size_t)(t + 1) * kstep;
            const char* a2 = last ? nA : cA + (size_t)(t + 2) * kstep; const char* b2 = last ? nB : cB + (size_t)(t + 2) * kstep;
            const char* a3 = a2 + kstep; const char* b3 = b2 + kstep;
            if (last && has_next) S.a_ready(nxt);
            if constexpr (SP2) {
            PG8_LDB(B0, 0, 0); PG8_LDB(B1, 0, 1); PG8_SCHED; PG8_LDA(At, 0, 0); PG8_STAGE(PG8_SA(1, 1), a1 + hstepA, voffA);
            PG8_WAIT_V(8); PG8_WAIT_L(0); PG8_BAR; PG8_MMA(0, 0, At, B0); PG8_MMA(0, 1, At, B1); PG8_BAR; PG8_SCHED;
            PG8_LDA(At, 0, 1); PG8_STAGE(PG8_SB(0, 0), b2, voffB); PG8_STAGE(PG8_SB(0, 1), b2 + hstepB, voffB); PG8_STAGE(PG8_SA(0, 0), a2, voffA);
            PG8_WAIT_V(8); PG8_WAIT_L(0); PG8_BAR; PG8_MMA(1, 0, At, B0); PG8_MMA(1, 1, At, B1); PG8_BAR; PG8_SCHED;
            PG8_LDB(B0, 1, 0); PG8_LDB(B1, 1, 1); PG8_SCHED; PG8_LDA(At, 1, 0); PG8_STAGE(PG8_SA(0, 1), a2 + hstepA, voffA);
            PG8_WAIT_V(8); PG8_WAIT_L(0); PG8_BAR; PG8_MMA(0, 0, At, B0); PG8_MMA(0, 1, At, B1); PG8_BAR; PG8_SCHED;
            PG8_LDA(At, 1, 1); PG8_STAGE(PG8_SB(1, 0), b3, voffB); PG8_STAGE(PG8_SB(1, 1), b3 + hstepB, voffB); PG8_STAGE(PG8_SA(1, 0), a3, voffA);
            PG8_WAIT_V(8); PG8_WAIT_L(0); PG8_BAR; PG8_MMA(1, 0, At, B0); PG8_MMA(1, 1, At, B1); PG8_BAR; PG8_SCHED;
            } else {
            PG8_LDB(B0, 0, 0); PG8_SCHED; PG8_LDA(At, 0, 0); PG8_STAGE(PG8_SA(1, 1), a1 + hstepA, voffA);
            PG8_WAIT_L(8); PG8_BAR; PG8_WAIT_L(0); PG8_MMA(0, 0, At, B0); PG8_BAR; PG8_SCHED;
            PG8_LDB(B1, 0, 1); PG8_STAGE(PG8_SB(0, 0), b2, voffB);
            PG8_BAR; PG8_WAIT_L(0); PG8_MMA(0, 1, At, B1); PG8_BAR;
            PG8_LDA(At, 0, 1); PG8_STAGE(PG8_SA(0, 0), a2, voffA);
            PG8_BAR; PG8_WAIT_L(0); PG8_MMA(1, 0, At, B0); PG8_BAR; PG8_SCHED;
            PG8_STAGE(PG8_SB(0, 1), b2 + hstepB, voffB);
            PG8_WAIT_V(6); PG8_BAR; PG8_MMA(1, 1, At, B1); PG8_BAR;
            PG8_LDB(B0, 1, 0); PG8_SCHED; PG8_LDA(At, 1, 0); PG8_STAGE(PG8_SA(0, 1), a2 + hstepA, voffA);
            PG8_WAIT_L(8); PG8_BAR; PG8_WAIT_L(0); PG8_MMA(0, 0, At, B0); PG8_BAR; PG8_SCHED;
            PG8_LDB(B1, 1, 1); PG8_STAGE(PG8_SB(1, 0), b3, voffB);
            PG8_BAR; PG8_WAIT_L(0); PG8_MMA(0, 1, At, B1); PG8_BAR;
            PG8_LDA(At, 1, 1); PG8_STAGE(PG8_SA(1, 0), a3, voffA);
            PG8_BAR; PG8_WAIT_L(0); PG8_MMA(1, 0, At, B0); PG8_BAR; PG8_SCHED;
            PG8_STAGE(PG8_SB(1, 1), b3 + hstepB, voffB);
            PG8_WAIT_V(6); PG8_BAR; PG8_MMA(1, 1, At, B1); PG8_BAR;
            }
        }
        if constexpr (ALIGN_EPI) { if (wr == 0) PG8_BAR; }
        if constexpr (!Epi::AFTER_DRAIN) { E(acc, cur, wr, wc, fr, fq); S.done(cur); }
        if (!has_next) break;
#pragma unroll
        for (int a = 0; a < 2; ++a)
#pragma unroll
            for (int b = 0; b < 2; ++b)
#pragma unroll
                for (int m = 0; m < 4; ++m)
#pragma unroll
                    for (int n = 0; n < 2; ++n) acc[a][b][m][n] = zero4();
        cur = nxt; cA = nA; cB = nB; ++ui;
        if constexpr (ALIGN_EPI) { if (wr == 1) PG8_BAR; }
    }
    PG8_WAIT_V(0);
    if constexpr (!ALIGN_EPI) { if (wr == 0) PG8_BAR; }
    PG8_BAR;
    if constexpr (Epi::AFTER_DRAIN) { E.fused(acc, cur, wr, wc, fr, fq, lds, wid, lane); S.done(cur); }
#undef PG8_SA
#undef PG8_SB
#undef PG8_STAGE
#undef PG8_LDA
#undef PG8_LDB
#undef PG8_MMA
#undef PG8_WAIT_V
#undef PG8_WAIT_L
#undef PG8_BAR
#undef PG8_SCHED
}
}

namespace attn {
using bf16 = __hip_bfloat16;
typedef short bf16x8 __attribute__((ext_vector_type(8)));
typedef short s16x4 __attribute__((ext_vector_type(4)));
typedef float f32x16 __attribute__((ext_vector_type(16)));
typedef float f32x4 __attribute__((ext_vector_type(4)));
typedef unsigned u32x4 __attribute__((ext_vector_type(4)));
constexpr int D = 128, DQK = 192;
constexpr float THR = 8.f;
constexpr float SCALE = 0.07216878364870322f;
constexpr int NW = 8, QBLK = 32, KVBLK = 64, QB = NW * QBLK;
constexpr int SHM_V = KVBLK * D * 2, SHM_K = KVBLK * D * 2, SHM_KP = KVBLK * 64 * 2;
constexpr int OFF_K = 2 * SHM_V, OFF_KP = OFF_K + 2 * SHM_K, OFF_WS = OFF_KP + 2 * SHM_KP, OFF_OST = OFF_WS + NW * 64 * 4, LDS_BYTES = OFF_OST + NW * 8192;
constexpr int NQD = DQK / 16;

#define KSWZ(row, colB) ((row) * 256 + ((colB) ^ (((row) & 7) << 4)))
#define SBAR() __builtin_amdgcn_sched_barrier(0)
__device__ __forceinline__ int v_st(int k, int c) { const int kk = (k & ~0xC) | ((k & 4) << 1) | ((k & 8) >> 1); return ((kk >> 3) * 4 + (c >> 5)) * 512 + ((kk & 7) * 32 + (c & 31)) * 2; }
__device__ __forceinline__ int v_rd_base(int lane) { return ((lane & 3) << 3) | (((lane >> 2) & 3) << 6) | (((lane >> 4) & 1) << 5) | (((lane >> 5) & 1) << 8); }
constexpr int v_rd_off(int d0, int ks, int half) { return d0 * 512 + ks * 4096 + half * 2048; }
__device__ __forceinline__ int crow(int r, int hi) { return (r & 3) + 8 * (r >> 2) + 4 * hi; }
__device__ __forceinline__ unsigned cvtpk(float lo, float hi) { unsigned r; asm volatile("v_cvt_pk_bf16_f32 %0, %1, %2" : "=v"(r) : "v"(lo), "v"(hi)); return r; }
__device__ __forceinline__ int opaque(int x) { asm volatile("" : "+v"(x)); return x; }
__device__ __forceinline__ bf16x8 load8(const bf16* p) { return *reinterpret_cast<const bf16x8*>(p); }
__device__ __forceinline__ void mask_tile(f32x16& p0, f32x16& p1, int dq) {
    const float NEG = -__builtin_inff();
#pragma unroll
    for (int r = 0; r < 16; ++r) {
        const int c = (r & 3) + 8 * (r >> 2);
        if (dq - c < 0) p0[r] = NEG;
        if (dq - c - 32 < 0) p1[r] = NEG;
    }
}
__device__ __forceinline__ void partialSM(f32x16& p0, f32x16& p1, float& m_reg, float& mn, float& alpha) {
    float pmax = p0[0];
#pragma unroll
    for (int r = 1; r < 16; ++r) pmax = fmaxf(pmax, p0[r]);
#pragma unroll
    for (int r = 0; r < 16; ++r) pmax = fmaxf(pmax, p1[r]);
    { auto rr = __builtin_amdgcn_permlane32_swap(__float_as_uint(pmax), __float_as_uint(pmax), false, false);
      pmax = fmaxf(__uint_as_float(rr[0]), __uint_as_float(rr[1])); }
    constexpr float C2 = 1.4426950408889634f * SCALE;
    if (__builtin_expect(__all((pmax - m_reg) * SCALE <= THR), 1)) { mn = m_reg; alpha = 1.f; }
    else { mn = fmaxf(m_reg, pmax); alpha = __builtin_amdgcn_exp2f((m_reg - mn) * C2); m_reg = mn; }
    const float mnL = -mn * C2;
#pragma unroll
    for (int r = 0; r < 16; ++r) p0[r] = fmaf(p0[r], C2, mnL);
#pragma unroll
    for (int r = 0; r < 16; ++r) p1[r] = fmaf(p1[r], C2, mnL);
#pragma unroll
    for (int r = 0; r < 16; ++r) p0[r] = __builtin_amdgcn_exp2f(p0[r]);
}
__device__ __forceinline__ void finishSM(f32x16& p0, f32x16& p1, float alpha, float& l_reg, bf16x8& pa0, bf16x8& pa1, bf16x8& pa2, bf16x8& pa3) {
#pragma unroll
    for (int r = 0; r < 16; ++r) p1[r] = __builtin_amdgcn_exp2f(p1[r]);
    float ps = 0;
#pragma unroll
    for (int r = 0; r < 16; ++r) ps += p0[r];
#pragma unroll
    for (int r = 0; r < 16; ++r) ps += p1[r];
    { auto rr = __builtin_amdgcn_permlane32_swap(__float_as_uint(ps), __float_as_uint(ps), false, false);
      ps = __uint_as_float(rr[0]) + __uint_as_float(rr[1]); }
    l_reg = l_reg * alpha + ps;
#define PK4(P, B_, OUT) do { unsigned a0 = cvtpk(P[B_+0], P[B_+1]), a1 = cvtpk(P[B_+2], P[B_+3]);                          \
        unsigned b0 = cvtpk(P[B_+4], P[B_+5]), b1 = cvtpk(P[B_+6], P[B_+7]);                                             \
        auto r0 = __builtin_amdgcn_permlane32_swap(a0, b0, false, false); auto r1 = __builtin_amdgcn_permlane32_swap(a1, b1, false, false); \
        u32x4 w = {r0[0], r1[0], r0[1], r1[1]}; OUT = *reinterpret_cast<bf16x8*>(&w); } while (0)
    PK4(p0, 0, pa0); PK4(p0, 8, pa1); PK4(p1, 0, pa2); PK4(p1, 8, pa3);
#undef PK4
}
template <int KB>
__device__ __forceinline__ void qkt(f32x16& p0, f32x16& p1, const char* K_lds, int r32, int hi, const bf16x8* qr, const char* qpl) {
    p0 = f32x16{}; p1 = f32x16{};
    const char* kb[4];
#pragma unroll
    for (int dd = 0; dd < 4; ++dd) kb[dd] = K_lds + KB * SHM_K + KSWZ(r32, (dd * 16 + hi * 8) * 2);
#pragma unroll
    for (int d0 = 0; d0 < 8; ++d0) { const char* a = kb[d0 & 3] + (d0 >> 2) * 128;
        bf16x8 b0 = *reinterpret_cast<const bf16x8*>(a);
        bf16x8 b1 = *reinterpret_cast<const bf16x8*>(a + 32 * 256);
        p0 = __builtin_amdgcn_mfma_f32_32x32x16_bf16(b0, qr[d0], p0, 0, 0, 0);
        p1 = __builtin_amdgcn_mfma_f32_32x32x16_bf16(b1, qr[d0], p1, 0, 0, 0); }
#pragma unroll
    for (int e = 0; e < 4; ++e) { const char* a = kb[e] + (2 * SHM_K - KB * SHM_K + KB * SHM_KP);
        bf16x8 b0 = *reinterpret_cast<const bf16x8*>(a);
        bf16x8 b1 = *reinterpret_cast<const bf16x8*>(a + 128);
        const bf16x8 qe = *reinterpret_cast<const bf16x8*>(qpl + e * 1024);
        p0 = __builtin_amdgcn_mfma_f32_32x32x16_bf16(b0, qe, p0, 0, 0, 0);
        p1 = __builtin_amdgcn_mfma_f32_32x32x16_bf16(b1, qe, p1, 0, 0, 0); }
}
template <int VB>
__device__ __forceinline__ void pv_tile(f32x16* o, int vb0, bf16x8 pa0, bf16x8 pa1, bf16x8 pa2, bf16x8 pa3) {
#define TRRD(dst, off) asm volatile("ds_read_b64_tr_b16 %0, %1 offset:%2" : "=&v"(dst) : "v"(vb0), "i"(off) : "memory")
#define PV_D0(d0) do { s16x4 l0, l1, l2, l3, h0, h1, h2, h3; constexpr int b_ = VB * SHM_V + v_rd_off(d0, 0, 0);     \
        TRRD(l0, b_); TRRD(h0, b_ + 2048); TRRD(l1, b_ + 4096); TRRD(h1, b_ + 6144); TRRD(l2, b_ + 8192); TRRD(h2, b_ + 10240); TRRD(l3, b_ + 12288); TRRD(h3, b_ + 14336); \
        asm volatile("s_waitcnt lgkmcnt(0)" ::: "memory"); SBAR();                                                                  \
        o[d0] = __builtin_amdgcn_mfma_f32_32x32x16_bf16(pa0, (bf16x8){l0[0], l0[1], l0[2], l0[3], h0[0], h0[1], h0[2], h0[3]}, o[d0], 0, 0, 0);   \
        o[d0] = __builtin_amdgcn_mfma_f32_32x32x16_bf16(pa1, (bf16x8){l1[0], l1[1], l1[2], l1[3], h1[0], h1[1], h1[2], h1[3]}, o[d0], 0, 0, 0);   \
        o[d0] = __builtin_amdgcn_mfma_f32_32x32x16_bf16(pa2, (bf16x8){l2[0], l2[1], l2[2], l2[3], h2[0], h2[1], h2[2], h2[3]}, o[d0], 0, 0, 0);   \
        o[d0] = __builtin_amdgcn_mfma_f32_32x32x16_bf16(pa3, (bf16x8){l3[0], l3[1], l3[2], l3[3], h3[0], h3[1], h3[2], h3[3]}, o[d0], 0, 0, 0); } while (0)
    PV_D0(0); PV_D0(1); PV_D0(2); PV_D0(3);
#undef PV_D0
#undef TRRD
}

typedef __amdgpu_buffer_rsrc_t rsrc_t;
struct BlockRef { unsigned q, kn, kp, o; int P0; };
struct Seam { bf16x8 qr[8]; bf16x8 qpe[4]; bf16x8 st_v0, st_v1, st_k0, st_k1, st_kp; };
__device__ __forceinline__ bf16x8 bld8(rsrc_t r, unsigned voff, unsigned soff) { const u32x4 v = __builtin_amdgcn_raw_buffer_load_b128(r, voff, soff, 0); return __builtin_bit_cast(bf16x8, v); }
#define VMW() asm volatile("s_waitcnt vmcnt(0)" ::: "memory")
#define VMWN(n) asm volatile("s_waitcnt vmcnt(%0)" :: "i"(n) : "memory")
#define SLOAD(R, k0) do { const unsigned so_ = (R).kn + (unsigned)(k0) * (KVP * 2), sp_ = (R).kp + (unsigned)(k0) * (ZP * 2);                       \
                          S.st_v0 = bld8(rs, vkv + 256, so_); S.st_v1 = bld8(rs, vkv + 256, so_ + 32 * KVP * 2);                                   \
                          S.st_k0 = bld8(rs, vkv, so_); S.st_k1 = bld8(rs, vkv, so_ + 32 * KVP * 2);                                               \
                          S.st_kp = bld8(rs, vkp, sp_); } while (0)
#define QLOAD(R) do { _Pragma("unroll") for (int d0 = 0; d0 < 8; ++d0) S.qr[d0] = bld8(rs, vq + d0 * 32, (R).q); } while (0)
#define QPLOAD(R) do { _Pragma("unroll") for (int e = 0; e < 4; ++e) S.qpe[e] = bld8(rs, vq + (8 + e) * 32, (R).q); } while (0)
#define QPWRITE() do { _Pragma("unroll") for (int e = 0; e < 4; ++e) *(bf16x8*)(qpl + e * 1024) = S.qpe[e]; } while (0)
#define SWRITE_K(bf) do { *(bf16x8*)(K_lds + (bf) * SHM_K + kws) = S.st_k0; *(bf16x8*)(K_lds + (bf) * SHM_K + kws + 32 * 256) = S.st_k1; \
                          *(bf16x8*)(KP_lds + (bf) * SHM_KP + kpw) = S.st_kp; } while (0)
#define SWRITE_V(bf) do { *(bf16x8*)(V_lds + (bf) * SHM_V + vst0) = S.st_v0; *(bf16x8*)(V_lds + (bf) * SHM_V + vst1) = S.st_v1; } while (0)
#define SWRITE_ALL(bf) do { SWRITE_V(bf); SWRITE_K(bf); } while (0)
__device__ __forceinline__ void attn_prime(const BlockRef& cur, rsrc_t rs, char* lds, Seam& S) {
    const int tid = opaque(threadIdx.x), wid = __builtin_amdgcn_readfirstlane(tid >> 6), lane = tid & 63, r32 = lane & 31, hi = lane >> 5;
    const int sr = tid >> 4, sc = (tid & 15) * 8, kws = KSWZ(sr, sc * 2), pr = tid >> 3, pc = tid & 7, kpw = KSWZ(pr & 31, ((pr >> 5) * 8 + pc) * 16);
    const unsigned vq = (unsigned)((wid * QBLK + r32) * QP + hi * 8) * 2u, vkv = (unsigned)(sr * KVP + sc) * 2u, vkp = (unsigned)(pr * ZP + pc * 8) * 2u;
    char* K_lds = lds + OFF_K; char* KP_lds = lds + OFF_KP;
    char* qpl = lds + OFF_OST + wid * 8192 + lane * 16;
    QLOAD(cur); QPLOAD(cur);
    SLOAD(cur, 0); VMW(); SWRITE_K(0); QPWRITE();
    __syncthreads();
}
__device__ __forceinline__ void attn_block(const BlockRef& cur, const BlockRef& nxt, rsrc_t rs, char* lds, Seam& S) {
    const int tid = opaque(threadIdx.x), wid = __builtin_amdgcn_readfirstlane(tid >> 6), lane = tid & 63, r32 = lane & 31, hi = lane >> 5;
    const int NT = (cur.P0 + QB) / KVBLK;
    const int qlo = cur.P0 + wid * QBLK, qm = qlo + r32 - 4 * hi;
    char* V_lds = lds; char* K_lds = lds + OFF_K; char* KP_lds = lds + OFF_KP;
    float* ws = (float*)(lds + OFF_WS) + wid * 64; float* li_l = ws, * al_l = ws + 32;
    float m_reg = -1e30f, l_reg = 0; f32x16 o[4] = {};
    const int sr = tid >> 4, sc = (tid & 15) * 8, vst0 = v_st(sr, sc), vst1 = v_st(32 + sr, sc), kws = KSWZ(sr, sc * 2);
    const int pr = tid >> 3, pc = tid & 7, kpw = KSWZ(pr & 31, ((pr >> 5) * 8 + pc) * 16);
    const int vb0 = (int)(uintptr_t)V_lds + v_rd_base(lane);
    char* qpl = lds + OFF_OST + wid * 8192 + lane * 16;
    const unsigned vkv = (unsigned)(sr * KVP + sc) * 2u, vkp = (unsigned)(pr * ZP + pc * 8) * 2u;
#define RESC(a) do { if (__any((a) < 1.f)) { if (hi == 0) al_l[r32] = (a); asm volatile("s_waitcnt lgkmcnt(0)" ::: "memory");              \
                     for (int d_ = 0; d_ < 4; ++d_) for (int r = 0; r < 16; ++r) o[d_][r] *= al_l[crow(r, hi)]; } } while (0)
#define KBASE(t) ((t) * KVBLK)
#define MASKT(P0_, P1_, t) do { const int kb_ = KBASE(t); if (kb_ + KVBLK - 1 > qlo) mask_tile(P0_, P1_, qm - kb_); } while (0)
    f32x16 pA0, pA1, pB0, pB1; float mnA, mnB, alA, alB; bf16x8 pa0, pa1, pa2, pa3;
    SWRITE_V(0); SBAR();
    if (NT > 1) { SLOAD(cur, KBASE(1)); }
    SBAR(); qkt<0>(pA0, pA1, K_lds, r32, hi, S.qr, qpl);
    MASKT(pA0, pA1, 0); partialSM(pA0, pA1, m_reg, mnA, alA);
    if (NT > 1) { VMW(); SWRITE_ALL(1); }
    __syncthreads();
#define HALF_STEP(PX0, PX1, mnX, alX, PY0, PY1, alY, t, KB, VB, SB) do {                                                      \
        SBAR(); qkt<KB>(PX0, PX1, K_lds, r32, hi, S.qr, qpl);                                                                      \
        finishSM(PY0, PY1, alY, l_reg, pa0, pa1, pa2, pa3); SBAR();                                                           \
        if ((t) + 1 < NT) { SLOAD(cur, KBASE((t) + 1)); SBAR(); }                                                             \
        pv_tile<VB>(o, vb0, pa0, pa1, pa2, pa3); MASKT(PX0, PX1, (t)); partialSM(PX0, PX1, m_reg, mnX, alX);                  \
        __syncthreads();                                                                                                      \
        if ((t) + 1 < NT) { VMW(); SWRITE_ALL(SB); }                                                                          \
        RESC(alX); __syncthreads(); } while (0)
    for (int t = 1; t + 1 < NT; t += 2) {
        HALF_STEP(pB0, pB1, mnB, alB, pA0, pA1, alA, t, 1, 0, 0);
        HALF_STEP(pA0, pA1, mnA, alA, pB0, pB1, alB, t + 1, 0, 1, 1);
    }
    SBAR(); qkt<1>(pB0, pB1, K_lds, r32, hi, S.qr, qpl); SBAR();
    finishSM(pA0, pA1, alA, l_reg, pa0, pa1, pa2, pa3); SBAR();
    pv_tile<0>(o, vb0, pa0, pa1, pa2, pa3);
    SBAR(); { const int l2 = opaque(lane); const unsigned vq = (unsigned)((wid * QBLK + (l2 & 31)) * QP + (l2 >> 5) * 8) * 2u; QLOAD(nxt); } SLOAD(nxt, 0); SBAR();
    MASKT(pB0, pB1, NT - 1); partialSM(pB0, pB1, m_reg, mnB, alB); __syncthreads(); RESC(alB);
    finishSM(pB0, pB1, alB, l_reg, pa0, pa1, pa2, pa3); SBAR(); pv_tile<1>(o, vb0, pa0, pa1, pa2, pa3);
    SBAR(); { const int l2 = opaque(lane); const unsigned vq = (unsigned)((wid * QBLK + (l2 & 31)) * QP + (l2 >> 5) * 8) * 2u; QPLOAD(nxt); }
    SBAR(); VMWN(4); SWRITE_K(0); SBAR();
    if (hi == 0) li_l[r32] = l_reg; asm volatile("s_waitcnt lgkmcnt(0)" ::: "memory");
    float rli[16];
#pragma unroll
    for (int r = 0; r < 16; ++r) rli[r] = __builtin_amdgcn_rcpf(li_l[crow(r, hi)]);
    bf16* stg = (bf16*)(lds + OFF_OST) + wid * 4096;
#pragma unroll
    for (int r = 0; r < 16; ++r) { const int orow = crow(r, hi);
#pragma unroll
        for (int d0 = 0; d0 < 4; ++d0) stg[orow * 128 + d0 * 32 + r32] = __float2bfloat16(o[d0][r] * rli[r]); }
    asm volatile("s_waitcnt lgkmcnt(0)" ::: "memory");
    { const int l3 = opaque(lane); const unsigned vo = (unsigned)((wid * QBLK + (l3 >> 4)) * 1024 + (l3 & 15) * 8) * 2u;
#pragma unroll
    for (int i = 0; i < 8; ++i) { const int row = i * 4 + (l3 >> 4), ch = l3 & 15;
        const u32x4 ov = *(const u32x4*)(stg + row * 128 + ch * 8);
        const u32x4 gv = __builtin_amdgcn_raw_buffer_load_b128(rs, vo, cur.o + (unsigned)(i * 4 * 1024 * 2), 0);
        u32x4 w;
#pragma unroll
        for (int j = 0; j < 4; ++j) { const float olo = __uint_as_float(ov[j] << 16), ohi = __uint_as_float(ov[j] & 0xffff0000u), glo = __uint_as_float(gv[j] << 16), ghi = __uint_as_float(gv[j] & 0xffff0000u);
            w[j] = cvtpk(olo * glo, ohi * ghi); }
        __builtin_amdgcn_raw_buffer_store_b128(w, rs, vo, cur.o + (unsigned)(i * 4 * 1024 * 2), 0); } }
    asm volatile("s_waitcnt lgkmcnt(0)" ::: "memory"); QPWRITE();
    __syncthreads();
#undef RESC
#undef KBASE
#undef MASKT
#undef HALF_STEP
}
#undef VMW
#undef VMWN
#undef SLOAD
#undef QLOAD
#undef QPLOAD
#undef QPWRITE
#undef SWRITE_K
#undef SWRITE_V
#undef SWRITE_ALL
#undef KSWZ
#undef SBAR
}

constexpr int NWAVES = 8;
constexpr int NSTEPS = 16;
constexpr size_t MiB = 1u << 20;
constexpr size_t WS_CTL = 0, CTL_ZERO_BYTES = 64 * 1024;
constexpr size_t WS_SSQ = 1 * MiB, WS_SSQL = 1 * MiB + 256 * 1024;
constexpr size_t WS_W = 2 * MiB;
constexpr size_t SZ_WINM = (size_t)ZN * 1024 * 2, SZ_WQB = (size_t)QP * Q_LORA * 2, SZ_WKVB = (size_t)KVP * KV_LORA * 2, SZ_WO = (size_t)1024 * 1024 * 2, SZ_WINC = (size_t)CONV_IN * 1024 * 2;
constexpr size_t WS_WINM = WS_W, WS_WQB = WS_WINM + 2 * SZ_WINM, WS_WKVB = WS_WQB + 2 * SZ_WQB, WS_WOM = WS_WKVB + 2 * SZ_WKVB, WS_WINC = WS_WOM + 2 * SZ_WO, WS_WOC = WS_WINC + 2 * SZ_WINC;
static_assert(WS_WOC + 2 * SZ_WO <= 34 * MiB, "weights region");
constexpr size_t WS_COS = 34 * MiB, WS_SIN = 36 * MiB;
constexpr size_t WS_OA = 38 * MiB;
constexpr size_t WS_ZM = 70 * MiB;
constexpr size_t WS_XB = 94 * MiB;
constexpr size_t WS_Q = 126 * MiB, WS_U = 126 * MiB;
constexpr size_t WS_KV = 174 * MiB, WS_G = 174 * MiB;
constexpr size_t WS_END = 238 * MiB;
constexpr int CW_BAR = 1024;
constexpr int RING_OFF = 0, MISC_OFF = 149504, LDS_BYTES = 150 * 1024;
static_assert(attn::LDS_BYTES <= MISC_OFF && pg8::STAGE_BYTES <= MISC_OFF, "LDS map");

#define GAS __attribute__((address_space(1)))
#define LAS __attribute__((address_space(3)))
typedef unsigned short bf16u;
typedef unsigned v4u __attribute__((ext_vector_type(4)));
typedef float f32x4 __attribute__((ext_vector_type(4)));
typedef float f32x2 __attribute__((ext_vector_type(2)));
typedef GAS unsigned gu32;
#define RLX_AGENT __ATOMIC_RELAXED, __HIP_MEMORY_SCOPE_AGENT
#define LDS_WAIT() asm volatile("s_waitcnt lgkmcnt(0)" ::: "memory")
__device__ __forceinline__ unsigned f2bf(float f) { unsigned u = __builtin_bit_cast(unsigned, f); return (u + 0x7fffu + ((u >> 16) & 1u)) >> 16; }
__device__ __forceinline__ unsigned pk2(float lo, float hi) { return f2bf(lo) | (f2bf(hi) << 16); }

#define XB_TMO      128
#define XB_XCNT(j)  (256  + 64 * (j))
#define XB_XSUB(j)  (1280 + 64 * (j))
#define XB_XGEN(j)  (2304 + 64 * (j))
#define XB_TOP      3328
#define XB_TOPGEN   3392
#define XCD_BAR_WORDS 3456
#define XB_SPIN_CAP (1u << 18)
__device__ __forceinline__ unsigned xb_ld(unsigned* p)              { return __hip_atomic_load(p, __ATOMIC_RELAXED, __HIP_MEMORY_SCOPE_AGENT); }
__device__ __forceinline__ unsigned xb_add(unsigned* p, unsigned v) { return __hip_atomic_fetch_add(p, v, __ATOMIC_RELAXED, __HIP_MEMORY_SCOPE_AGENT); }
__device__ __forceinline__ unsigned xb_xcc_id() { return (unsigned)__builtin_amdgcn_s_getreg((3 << 11) | 20) & 0xFu; }
#define XB_SPIN(cond, bar) do { unsigned _sp = 0; while (cond) { __builtin_amdgcn_s_sleep(1); \
    if ((++_sp & 255u) == 0u) { if (xb_ld(&(bar)[XB_TMO])) break; if (_sp > XB_SPIN_CAP) { atomicAdd(&(bar)[XB_TMO], 1u); break; } } } } while (0)
struct XcdBarrier { unsigned* bar; unsigned x; volatile LAS unsigned* st; };
__device__ __forceinline__ XcdBarrier xcd_barrier_post(unsigned* bar, volatile LAS unsigned* st) {
    XcdBarrier b; b.bar = bar; b.x = xb_xcc_id(); b.st = st;
    if (threadIdx.x == 0) (void)xb_add(&bar[XB_XCNT(b.x)], 1u);
    return b;
}
__device__ __forceinline__ void xcd_barrier_complete(unsigned* bar, unsigned x, unsigned& nloc, unsigned& nx) {
    const unsigned G = gridDim.x * gridDim.y * gridDim.z;
    unsigned sum, cnt, mine, sp = 0u;
    for (;;) {
        sum = 0u; cnt = 0u; mine = 0u;
#pragma unroll
        for (unsigned j = 0; j < 16; ++j) { const unsigned c = xb_ld(&bar[XB_XCNT(j)]); sum += c; cnt += (c > 0u) ? 1u : 0u; mine = (j == x) ? c : mine; }
        if (sum == G) break;
        __builtin_amdgcn_s_sleep(1);
        if ((++sp & 255u) == 0u) { if (xb_ld(&bar[XB_TMO])) break; if (sp > XB_SPIN_CAP) { atomicAdd(&bar[XB_TMO], 1u); break; } }
    }
    nloc = mine > 0u ? mine : 1u; nx = cnt > 0u ? cnt : 1u;
}
__device__ __forceinline__ void xcd_barrier(const XcdBarrier& b) {
    asm volatile("s_waitcnt vmcnt(0)" ::: "memory");
    __syncthreads();
    if (threadIdx.x == 0) {
        unsigned* bar = b.bar;
        __builtin_amdgcn_s_waitcnt(0);
        unsigned nloc = b.st[0], nx = b.st[1];
        if (nloc == 0u) { xcd_barrier_complete(bar, b.x, nloc, nx); b.st[0] = nloc; b.st[1] = nx; }
        const unsigned old = xb_add(&bar[XB_XSUB(b.x)], 1u);
        const unsigned gen = old / nloc;
        if (old + 1u == (gen + 1u) * nloc) {
            __builtin_amdgcn_fence(__ATOMIC_RELEASE, "agent");
            asm volatile("s_waitcnt vmcnt(0)" ::: "memory");
            const unsigned og = xb_add(&bar[XB_TOP], 1u);
            const unsigned tg = og / nx;
            if (og + 1u == (tg + 1u) * nx) xb_add(&bar[XB_TOPGEN], 1u);
            else XB_SPIN(xb_ld(&bar[XB_TOPGEN]) == tg, bar);
            __builtin_amdgcn_fence(__ATOMIC_ACQUIRE, "agent");
            xb_add(&bar[XB_XGEN(b.x)], 1u);
            asm volatile("s_waitcnt vmcnt(0)" ::: "memory");
        } else {
            XB_SPIN(xb_ld(&bar[XB_XGEN(b.x)]) == gen, bar);
            __builtin_amdgcn_fence(__ATOMIC_ACQUIRE, "agent");
            asm volatile("s_waitcnt vmcnt(0)" ::: "memory");
        }
    }
    __syncthreads();
}

__device__ __forceinline__ float wave_sum(float v) {
#pragma unroll
    for (int o = 1; o < 64; o <<= 1) v += __shfl_xor(v, o);
    return v;
}

template <int MAP> __device__ __forceinline__ int dst_row(int n) {
    if (MAP == 1) {
        if (n < 384) return n;
        if (n < 640) return Z_KV + (n - 384);
        if (n < 704) { const int j = n - 640; return Z_KPE + (j < 32 ? 2 * j : 2 * (j - 32) + 1); }
        return Z_GATE + (n - 704);
    }
    if (MAP == 2) {
        const int h = n / 192, d = n % 192; if (d < 128) return n; const int j = d - 128; return h * 192 + 128 + (j < 32 ? 2 * j : 2 * (j - 32) + 1);
    }
    if (MAP == 3) {
        if (n < 2048) { const int c = n & 1023, isb = n >> 10; return 256 * (c >> 7) + 2 * (c & 127) + isb; }
        return n;
    }
    return n;
}
template <int MAP>
__device__ __forceinline__ void p0_transpose_item(const float* W, int K, int N, bf16u* WT, const float* gain, LAS float* scr, int item, int lane) {
    const int nblk = N / 32, kb = item / nblk, nb = item % nblk, k0 = 64 * kb, n0 = 32 * nb;
    float wv[32];
#pragma unroll
    for (int i = 0; i < 32; ++i) { const int kk = 2 * i + (lane >> 5); wv[i] = W[(size_t)(k0 + kk) * N + n0 + (lane & 31)]; }
#pragma unroll
    for (int i = 0; i < 32; ++i) { const int kk = 2 * i + (lane >> 5); const float gk = gain ? gain[k0 + kk] : 1.f; scr[kk * 33 + (lane & 31)] = wv[i] * gk; }
    LDS_WAIT(); asm volatile("" ::: "memory");
    const int c = lane & 7;
#pragma unroll
    for (int j = 0; j < 4; ++j) { const int n = (lane >> 3) + 8 * j; const LAS float* s = scr + (8 * c) * 33 + n;
        v4u o; o.x = pk2(s[0 * 33], s[1 * 33]); o.y = pk2(s[2 * 33], s[3 * 33]); o.z = pk2(s[4 * 33], s[5 * 33]); o.w = pk2(s[6 * 33], s[7 * 33]);
        *(GAS v4u*)(WT + (size_t)dst_row<MAP>(n0 + n) * K + k0 + 8 * c) = o; }
    LDS_WAIT(); asm volatile("" ::: "memory");
}

__constant__ float c_inv_freq[32] = {
    1.0f, 0.7498942093324559f, 0.5623413251903491f, 0.4216965034285822f, 0.31622776601683794f, 0.23713737056616552f, 0.1778279410038923f, 0.1333521432163324f,
    0.1f, 0.07498942093324558f, 0.05623413251903491f, 0.04216965034285822f, 0.03162277660168379f, 0.023713737056616554f, 0.01778279410038923f, 0.01333521432163324f,
    0.01f, 0.007498942093324558f, 0.005623413251903491f, 0.004216965034285823f, 0.0031622776601683794f, 0.0023713737056616554f, 0.0017782794100389228f, 0.001333521432163324f,
    0.001f, 0.0007498942093324559f, 0.0005623413251903491f, 0.00042169650342858224f, 0.00031622776601683794f, 0.00023713737056616554f, 0.00017782794100389227f, 0.0001333521432163324f };


#ifndef PROBE_KIND
#define PROBE_KIND -1
#endif
struct Args { const void* in[19]; float* out; unsigned char* ws; int lo, hi; };
typedef __amdgpu_buffer_rsrc_t rsrc_t;

#define DPP_ADD(v, ctrl, rmask) v += __builtin_bit_cast(float, __builtin_amdgcn_update_dpp(0, __builtin_bit_cast(int, v), ctrl, rmask, 0xF, false))
__device__ __forceinline__ float wave_sum_to_lane63(float v) {
    DPP_ADD(v, 0xB1, 0xF); DPP_ADD(v, 0x4E, 0xF); DPP_ADD(v, 0x141, 0xF); DPP_ADD(v, 0x140, 0xF); DPP_ADD(v, 0x142, 0xA); DPP_ADD(v, 0x143, 0xC);
    return v;
}
#undef DPP_ADD
__device__ __forceinline__ void conv_phase(rsrc_t rs, const float* dw_w, const float* dw_b, const float* ln_g, const float* ln_b, int vcu, int G, LAS unsigned char* lds) {
    const int tid = pg8::opaque((int)threadIdx.x), lane = tid & 63, wid = __builtin_amdgcn_readfirstlane(tid >> 6);
    const int c = 2 * tid; const unsigned vo = (unsigned)tid * 4u;
    const rsrc_t rw = __builtin_amdgcn_make_buffer_rsrc((void*)dw_w, 0, CONV_K * 1024 * 4, 0x00020000);
    f32x2 wk[CONV_K];
#pragma unroll
    for (int k = 0; k < CONV_K; ++k) wk[k] = __builtin_bit_cast(f32x2, __builtin_amdgcn_raw_buffer_load_b64(rw, vo * 2u, (unsigned)(k * 4096), 0));
    const f32x2 db = *(const f32x2*)(dw_b + c), lg = *(const f32x2*)(ln_g + c), lb = *(const f32x2*)(ln_b + c);
    LAS float* red = (LAS float*)lds;
    LAS float* stat = (LAS float*)(lds + 4096);
#define SOFF(base_, row_) ((unsigned)__builtin_amdgcn_readfirstlane((int)((unsigned)(base_) + (unsigned)(row_) * 2048u)))
    for (int tile = vcu; tile < MTOK / 32; tile += G) {
        const int b = tile >> 6, t0 = (tile & 63) * 32; const unsigned rowbase = (unsigned)b * SEQ;
#define CONV_LD(r_) __builtin_amdgcn_raw_buffer_load_b32(rs, vo, SOFF(WS_U, rowbase + (unsigned)((t0 - 30 + (r_)) < 0 ? 0 : (t0 - 30 + (r_)))), 0)
        f32x2 av[32];
#pragma unroll
        for (int t = 0; t < 32; ++t) av[t] = (f32x2){0.f, 0.f};
        unsigned ucur[8], unxt[8];
#pragma unroll
        for (int i = 0; i < 8; ++i) ucur[i] = CONV_LD(i);
#pragma unroll
        for (int g = 0; g < 8; ++g) {
#pragma unroll
            for (int i = 0; i < 8; ++i) { const int r = (g + 1) * 8 + i; unxt[i] = (r < 62) ? CONV_LD(r) : 0u; }
            asm volatile("" ::: "memory"); __builtin_amdgcn_sched_barrier(0);
#pragma unroll
            for (int i = 0; i < 8; ++i) { const int r = g * 8 + i;
                if (r < 62) { const unsigned uv = (t0 - 30 + r < 0) ? 0u : ucur[i];
                    const f32x2 u2 = {__uint_as_float(uv << 16), __uint_as_float(uv & 0xffff0000u)};
#pragma unroll
                    for (int t = 0; t < 32; ++t) { const int k = r - t; if (k >= 0 && k < CONV_K) av[t] = __builtin_elementwise_fma(wk[k], u2, av[t]); } } }
#pragma unroll
            for (int i = 0; i < 8; ++i) ucur[i] = unxt[i];
        }
#undef CONV_LD
        __builtin_amdgcn_sched_barrier(0);
        unsigned gv[32];
#pragma unroll
        for (int t = 0; t < 32; ++t) gv[t] = __builtin_amdgcn_raw_buffer_load_b32(rs, vo, SOFF(WS_G, rowbase + (unsigned)(t0 + t)), 0);
        asm volatile("" ::: "memory"); __builtin_amdgcn_sched_barrier(0);
#pragma unroll
        for (int t = 0; t < 32; ++t) {
            av[t] += db;
            const float s1 = wave_sum_to_lane63(av[t].x + av[t].y), s2 = wave_sum_to_lane63(av[t].x * av[t].x + av[t].y * av[t].y);
            if (lane == 63) *(LAS f32x2*)(red + (t * 8 + wid) * 2) = (f32x2){s1, s2};
            if ((t & 3) == 3) __builtin_amdgcn_sched_barrier(0);
        }
        LDS_WAIT(); __syncthreads();
        if (tid < 32) { float s1 = 0.f, s2 = 0.f;
#pragma unroll
            for (int w = 0; w < 8; ++w) { const f32x2 p = *(const LAS f32x2*)(red + (tid * 8 + w) * 2); s1 += p.x; s2 += p.y; }
            const float mean = s1 * (1.f / 1024.f), var = s2 * (1.f / 1024.f) - mean * mean;
            *(LAS f32x2*)(stat + tid * 2) = (f32x2){mean, rsqrtf(var + LN_EPS)}; }
        LDS_WAIT(); __syncthreads();
#pragma unroll
        for (int t = 0; t < 32; ++t) {
            const f32x2 st = *(const LAS f32x2*)(stat + t * 2);
            const float y0 = (av[t].x - st.x) * st.y * lg.x + lb.x, y1 = (av[t].y - st.x) * st.y * lg.y + lb.y;
            const float o0 = pg8::silu_f(y0) * __uint_as_float(gv[t] << 16), o1 = pg8::silu_f(y1) * __uint_as_float(gv[t] & 0xffff0000u);
            __builtin_amdgcn_raw_buffer_store_b32(pg8::cvt_pk_bf16(o0, o1), rs, vo, SOFF(WS_OA, rowbase + (unsigned)(t0 + t)), 0);
            if ((t & 7) == 7) __builtin_amdgcn_sched_barrier(0);
        }
        LDS_WAIT(); __syncthreads();
    }
#undef SOFF
}

__device__ __forceinline__ attn::BlockRef attn_mkref(int Lq, int pass) {
    const int bh = Lq >> 2, xq = Lq & 3, b = bh >> 3, h = bh & 7, qb = pass ? 7 - xq : xq;
    const unsigned r0 = (unsigned)b * SEQ, rq = r0 + (unsigned)qb * 256;
    attn::BlockRef R;
    R.q = (unsigned)WS_Q + (rq * QP + h * 192) * 2u; R.kn = (unsigned)WS_KV + (r0 * KVP + h * 256) * 2u;
    R.kp = (unsigned)WS_ZM + (r0 * ZP + Z_KPE) * 2u; R.o = (unsigned)WS_OA + (rq * 1024 + h * 128) * 2u; R.P0 = qb * 256;
    return R;
}

enum { K_PRO = 0, K_MIN = 1, K_Q = 2, K_KV = 3, K_ATT = 4, K_OUT = 5, K_CIN = 6, K_CMID = 7, K_FIN = 8 };
template <int KIND>
__device__ __forceinline__ void phase(const Args& args, int j, bool last_out, bool is_conv, unsigned char* lds, bool dup = false) {
    LAS unsigned char* L = (LAS unsigned char*)lds;
    const int tid = pg8::opaque((int)threadIdx.x), lane = tid & 63, wave = __builtin_amdgcn_readfirstlane(tid >> 6);
    int G = gridDim.x, bx = blockIdx.x; unsigned char* ws = args.ws;
    asm volatile("" : "+s"(G), "+s"(bx), "+s"(ws));
    const int vcu = (G % 8 == 0) ? (bx % 8) * (G / 8) + bx / 8 : bx;
    const int gw = vcu * NWAVES + wave, NGW = G * NWAVES;
    float* SSQ = (float*)(ws + WS_SSQ); float* SSQL = (float*)(ws + WS_SSQL);
    float* COS = (float*)(ws + WS_COS); float* SIN = (float*)(ws + WS_SIN);
    if constexpr (KIND == K_PRO) {
        const float* x_in = (const float*)args.in[0]; bf16u* XB = (bf16u*)(ws + WS_XB);
        LAS float* scr = (LAS float*)(L + RING_OFF + wave * 16384);
        constexpr int I_MIN = 16 * (MLA_IN / 32), I_QB = 6 * (QP / 32), I_KVB = 4 * (KVP / 32), I_O = 16 * 32, I_CIN = 16 * (CONV_IN / 32);
        constexpr int PER = I_MIN + I_QB + I_KVB + I_O + I_CIN + I_O;
        for (int it = gw; it < 2 * PER; it += NGW) {
            const int jj = it / PER; int r = it % PER;
            if (r < I_MIN) { p0_transpose_item<1>((const float*)args.in[4] + (size_t)jj * 1024 * MLA_IN, 1024, MLA_IN, (bf16u*)(ws + WS_WINM + jj * SZ_WINM), (const float*)args.in[3] + jj * 1024, scr, r, lane); continue; } r -= I_MIN;
            if (r < I_QB) { p0_transpose_item<2>((const float*)args.in[6] + (size_t)jj * Q_LORA * QP, Q_LORA, QP, (bf16u*)(ws + WS_WQB + jj * SZ_WQB), (const float*)args.in[5] + jj * Q_LORA, scr, r, lane); continue; } r -= I_QB;
            if (r < I_KVB) { p0_transpose_item<0>((const float*)args.in[8] + (size_t)jj * KV_LORA * KVP, KV_LORA, KVP, (bf16u*)(ws + WS_WKVB + jj * SZ_WKVB), (const float*)args.in[7] + jj * KV_LORA, scr, r, lane); continue; } r -= I_KVB;
            if (r < I_O) { p0_transpose_item<0>((const float*)args.in[9] + (size_t)jj * 1024 * 1024, 1024, 1024, (bf16u*)(ws + WS_WOM + jj * SZ_WO), nullptr, scr, r, lane); continue; } r -= I_O;
            if (r < I_CIN) { p0_transpose_item<3>((const float*)args.in[11] + (size_t)jj * 1024 * CONV_IN, 1024, CONV_IN, (bf16u*)(ws + WS_WINC + jj * SZ_WINC), (const float*)args.in[10] + jj * 1024, scr, r, lane); continue; } r -= I_CIN;
            p0_transpose_item<0>((const float*)args.in[17] + (size_t)jj * 1024 * 1024, 1024, 1024, (bf16u*)(ws + WS_WOC + jj * SZ_WO), nullptr, scr, r, lane);
        }
        for (int i = gw * 64 + lane; i < 2 * 64 * 128; i += NGW * 64) { const int jj = i / (64 * 128), rr = (i / 128) % 64, cc = i % 128;
            unsigned z = 0u; asm volatile("" : "+v"(z));
            *(GAS v4u*)(ws + WS_WINM + jj * SZ_WINM + (size_t)(448 + rr) * 2048 + cc * 16) = (v4u){z, z, z, z}; }
        for (int m0 = gw * 4; m0 < MTOK; m0 += NGW * 4) {
            f32x4 v[4][4]; float ss[4];
#pragma unroll
            for (int i = 0; i < 4; ++i) { const GAS f32x4* xr = (const GAS f32x4*)(x_in + (size_t)(m0 + i) * 1024) + lane;
#pragma unroll
                for (int q = 0; q < 4; ++q) v[i][q] = xr[64 * q]; }
#pragma unroll
            for (int i = 0; i < 4; ++i) { float s_ = 0.f;
#pragma unroll
                for (int q = 0; q < 4; ++q) s_ += (v[i][q].x * v[i][q].x + v[i][q].y * v[i][q].y) + (v[i][q].z * v[i][q].z + v[i][q].w * v[i][q].w);
                ss[i] = wave_sum(s_); }
#pragma unroll
            for (int i = 0; i < 4; ++i) { GAS unsigned long long* o8 = (GAS unsigned long long*)(XB + (size_t)(m0 + i) * 1024) + lane;
#pragma unroll
                for (int q = 0; q < 4; ++q) o8[64 * q] = (unsigned long long)pk2(v[i][q].x, v[i][q].y) | ((unsigned long long)pk2(v[i][q].z, v[i][q].w) << 32);
                if (lane == 0) *(f32x4*)(SSQ + (size_t)(m0 + i) * 4) = (f32x4){ss[i], 0.f, 0.f, 0.f}; }
        }
        const int* pos = (const int*)args.in[1];
        for (int i = gw * 64 + lane; i < MTOK * 32; i += NGW * 64) {
            const int m = i >> 5, fi = i & 31;
            const float ang = (float)pos[m] * c_inv_freq[fi];
            const double rev = (double)ang * 0.15915494309189535; const float fr = (float)(rev - __builtin_rint(rev));
            COS[i] = __builtin_amdgcn_cosf(fr); SIN[i] = __builtin_amdgcn_sinf(fr);
        }
    }
    if constexpr (KIND == K_FIN) {
        const float* gfin = (const float*)args.in[2]; float* xs = args.out; float* xo = dup ? (float*)(ws + WS_KV) : args.out;
        for (int m = gw; m < MTOK; m += NGW) {
            const f32x4 sx = *(const f32x4*)(SSQ + (size_t)m * 4);
            const float rstd = rsqrtf(((sx[0] + sx[1]) + (sx[2] + sx[3])) * (1.0f / 1024.0f) + RMS_EPS);
            GAS f32x4* xr = (GAS f32x4*)(xs + (size_t)m * 1024) + lane; GAS f32x4* xw = (GAS f32x4*)(xo + (size_t)m * 1024) + lane;
#pragma unroll
            for (int q = 0; q < 4; ++q) { const f32x4 g4 = *((const f32x4*)gfin + lane + 64 * q); f32x4 v = xr[64 * q]; v = v * rstd * g4; xw[64 * q] = v; }
        }
    }
    if constexpr (KIND == K_MIN) {
        pg8::Gemm g{(const bf16u*)(ws + WS_XB), (const bf16u*)(ws + WS_WINM + j * SZ_WINM), MTOK, ZN, 1024, 1024}; pg8::StaticOrder S; S.init(MTOK, ZN, G, bx);
        pg8::EpiMlaIn E{(bf16u*)(ws + WS_ZM), (bf16u*)(ws + WS_OA), SSQ, SSQL, COS, SIN};
        pg8::gemm_phase<pg8::EpiMlaIn, pg8::StaticOrder, true, true>(L + RING_OFF, g, S, E);
    }
    if constexpr (KIND == K_Q) {
        pg8::Gemm g{(const bf16u*)(ws + WS_ZM), (const bf16u*)(ws + WS_WQB + j * SZ_WQB), MTOK, QP, Q_LORA, ZP}; pg8::StaticOrder S; S.init(MTOK, QP, G, bx);
        pg8::EpiQ E{(bf16u*)(ws + WS_Q), SSQL, COS, SIN};
        pg8::gemm_phase<pg8::EpiQ, pg8::StaticOrder, true, true>(L + RING_OFF, g, S, E);
    }
    if constexpr (KIND == K_KV) {
        pg8::Gemm g{(const bf16u*)(ws + WS_ZM) + Z_KV, (const bf16u*)(ws + WS_WKVB + j * SZ_WKVB), MTOK, KVP, KV_LORA, ZP}; pg8::StaticOrder S; S.init(MTOK, KVP, G, bx);
        pg8::EpiKV E{(bf16u*)(ws + WS_KV), SSQL};
        pg8::gemm_phase<pg8::EpiKV, pg8::StaticOrder, true, true>(L + RING_OFF, g, S, E);
    }
    if constexpr (KIND == K_ATT) {
        const rsrc_t rs = __builtin_amdgcn_make_buffer_rsrc((void*)ws, 0, (unsigned)WS_END, 0x00020000);
        attn::Seam SM; bool primed = false;
        attn::BlockRef cur{};
        for (int Lq = vcu; Lq < 256; Lq += G) {
            for (int pass = 0; pass < 2; ++pass) {
                if (!primed) { cur = attn_mkref(Lq, pass); attn::attn_prime(cur, rs, (char*)lds, SM); primed = true; }
                const bool last = (pass == 1) && (Lq + G >= 256);
                const attn::BlockRef nxt = last ? cur : (pass == 0 ? attn_mkref(Lq, 1) : attn_mkref(Lq + G, 0));
                attn::attn_block(cur, nxt, rs, (char*)lds, SM);
                cur = nxt;
            }
        }
        asm volatile("s_waitcnt vmcnt(0)" ::: "memory"); __syncthreads();
    }
    if constexpr (KIND == K_OUT) {
        const bf16u* Wt = (const bf16u*)(ws + (is_conv ? WS_WOC : WS_WOM) + j * SZ_WO);
        pg8::Gemm g{(const bf16u*)(ws + WS_OA), Wt, MTOK, 1024, 1024, 1024}; pg8::StaticOrder S; S.init(MTOK, 1024, G, bx);
        pg8::EpiResid E{(const bf16u*)(ws + WS_XB), (bf16u*)(ws + (dup ? WS_KV : WS_XB)), (last_out && !dup) ? args.out : nullptr, dup ? SSQL : SSQ, is_conv ? (const float*)args.in[18] + j * 1024 : nullptr};
        pg8::gemm_phase<pg8::EpiResid, pg8::StaticOrder, false, true>(L + RING_OFF, g, S, E);
    }
    if constexpr (KIND == K_CIN) {
        pg8::Gemm g{(const bf16u*)(ws + WS_XB), (const bf16u*)(ws + WS_WINC + j * SZ_WINC), MTOK, CONV_IN, 1024, 1024}; pg8::StaticOrder S; S.init(MTOK, CONV_IN, G, bx);
        pg8::EpiConvIn E{(bf16u*)(ws + WS_U), (bf16u*)(ws + WS_G), SSQ, (const float*)args.in[12] + j * CONV_IN};
        pg8::gemm_phase<pg8::EpiConvIn, pg8::StaticOrder, true, true>(L + RING_OFF, g, S, E);
    }
    if constexpr (KIND == K_CMID) {
        const rsrc_t rs = __builtin_amdgcn_make_buffer_rsrc((void*)ws, 0, (unsigned)WS_END, 0x00020000);
        conv_phase(rs, (const float*)args.in[13] + j * CONV_K * 1024, (const float*)args.in[14] + j * 1024, (const float*)args.in[15] + j * 1024, (const float*)args.in[16] + j * 1024, vcu, G, L + RING_OFF);
    }
}

#if MK_STEPWISE
template <int KIND>
__global__ void __launch_bounds__(NWAVES * 64, 2) step_kernel(Args args) {
    extern __shared__ __attribute__((aligned(16))) unsigned char lds[];
    const int s = args.lo, r7 = (s - 1) % 7, j = (s - 1) / 7;
    phase<KIND>(args, j, s == NSTEPS - 2, r7 == 6, lds);
}
template <int KIND> static void launch_step(Args a, int s, int grid, hipStream_t stream) {
    static bool done = false;
    if (!done) { done = true; (void)hipFuncSetAttribute((const void*)step_kernel<KIND>, hipFuncAttributeMaxDynamicSharedMemorySize, LDS_BYTES); }
    a.lo = s; a.hi = s + 1;
    hipLaunchKernelGGL(step_kernel<KIND>, dim3(grid), dim3(NWAVES * 64), LDS_BYTES, stream, a);
}
#else
__global__ void __launch_bounds__(NWAVES * 64, 2) trunk_fwd(Args args) {
    extern __shared__ __attribute__((aligned(16))) unsigned char lds[];
    volatile LAS unsigned* MISC = (volatile LAS unsigned*)((LAS unsigned char*)lds + MISC_OFF);
    if (threadIdx.x < 32) MISC[threadIdx.x] = 0u;
    __syncthreads();
    XcdBarrier bar = xcd_barrier_post((unsigned*)(args.ws + WS_CTL) + CW_BAR, MISC + 8);
    for (int s = args.lo; s < args.hi; ++s) {
        const int r7 = (s - 1) % 7, j = (s - 1) / 7;
#define RUNP(K, ...) do { if (PROBE_KIND == (K)) { phase<K>(__VA_ARGS__, true); } phase<K>(__VA_ARGS__); } while (0)
        if (s == 0) RUNP(K_PRO, args, 0, false, false, lds);
        else if (s == NSTEPS - 1) RUNP(K_FIN, args, 0, false, false, lds);
        else if (r7 == 0) RUNP(K_MIN, args, j, false, false, lds);
        else if (r7 == 1) { RUNP(K_Q, args, j, false, false, lds); RUNP(K_KV, args, j, false, false, lds); }
        else if (r7 == 2) RUNP(K_ATT, args, j, false, false, lds);
        else if (r7 == 3 || r7 == 6) RUNP(K_OUT, args, j, s == NSTEPS - 2, r7 == 6, lds);
        else if (r7 == 4) RUNP(K_CIN, args, j, false, false, lds);
        else RUNP(K_CMID, args, j, false, false, lds);
#undef RUNP
        if (s + 1 < args.hi) { xcd_barrier(bar); if (PROBE_KIND == 9) xcd_barrier(bar); }
    }
}
#endif

extern "C" void kernel_launch(void* const* d_in, const int* in_sizes, int n_in, void* d_out, int out_size, void* d_ws, size_t ws_size, hipStream_t stream) {
    static int grid = 0;
    if (grid == 0) {
        if (n_in != 19 || in_sizes[0] != MTOK * D_MODEL || out_size != MTOK * D_MODEL || ws_size < WS_END) {
            fprintf(stderr, "kernel_launch: unexpected shapes (n_in %d, in0 %d, out %d, ws %zu); nothing launched\n", n_in, n_in > 0 ? in_sizes[0] : -1, out_size, ws_size); grid = -1; return; }
        int dev = 0, cus = 0;
        if (hipGetDevice(&dev) != hipSuccess || hipDeviceGetAttribute(&cus, hipDeviceAttributeMultiprocessorCount, dev) != hipSuccess) { grid = -1; return; }
#if !MK_STEPWISE
        int per_cu = 0;
        if (hipFuncSetAttribute((const void*)trunk_fwd, hipFuncAttributeMaxDynamicSharedMemorySize, LDS_BYTES) != hipSuccess) { fprintf(stderr, "kernel_launch: hipFuncSetAttribute failed\n"); grid = -1; return; }
        if (hipOccupancyMaxActiveBlocksPerMultiprocessor(&per_cu, (const void*)trunk_fwd, NWAVES * 64, LDS_BYTES) != hipSuccess || per_cu < 1) { fprintf(stderr, "kernel_launch: occupancy query says %d blocks per CU\n", per_cu); (void)hipGetLastError(); }
#endif
        grid = cus;
    }
    if (grid < 0) return;
    Args a{};
    for (int i = 0; i < 19; ++i) a.in[i] = d_in[i];
    a.out = (float*)d_out; a.ws = (unsigned char*)d_ws;
#if MK_STEPWISE
    for (int s = 0; s < NSTEPS; ++s) {
        const int r7 = (s - 1) % 7;
        if (s == 0) launch_step<K_PRO>(a, s, grid, stream);
        else if (s == NSTEPS - 1) launch_step<K_FIN>(a, s, grid, stream);
        else if (r7 == 0) launch_step<K_MIN>(a, s, grid, stream);
        else if (r7 == 1) { launch_step<K_Q>(a, s, grid, stream); launch_step<K_KV>(a, s, grid, stream); }
        else if (r7 == 2) launch_step<K_ATT>(a, s, grid, stream);
        else if (r7 == 3 || r7 == 6) launch_step<K_OUT>(a, s, grid, stream);
        else if (r7 == 4) launch_step<K_CIN>(a, s, grid, stream);
        else launch_step<K_CMID>(a, s, grid, stream);
    }
#else
    if (hipMemsetAsync((char*)d_ws + WS_CTL, 0, CTL_ZERO_BYTES, stream) != hipSuccess) return;
    a.lo = 0; a.hi = NSTEPS;
    hipLaunchKernelGGL(trunk_fwd, dim3(grid), dim3(NWAVES * 64), LDS_BYTES, stream, a);
    const hipError_t e = hipPeekAtLastError();
    if (e != hipSuccess) fprintf(stderr, "kernel_launch: launch failed: %s (grid %d)\n", hipGetErrorString(e), grid);
#endif
}
```

```cpp
#include <hip/hip_runtime.h>
#include <hip/hip_bf16.h>
#include <cstdio>
#include <cstdint>

#ifndef MK_STEPWISE
#define MK_STEPWISE 0
#endif

constexpr int D_MODEL = 1024, BATCH = 8, SEQ = 2048, MTOK = BATCH * SEQ;
constexpr int N_HEADS = 8, QK_NOPE = 128, QK_ROPE = 64, V_HEAD = 128, Q_LORA = 384, KV_LORA = 256;
constexpr int MLA_IN = Q_LORA + KV_LORA + QK_ROPE + N_HEADS * V_HEAD;
constexpr int ZN = 1792;
constexpr int ZP = 768;
constexpr int Z_KPE = 384, Z_KV = 512, Z_GATE = 768;
constexpr int QP = N_HEADS * (QK_NOPE + QK_ROPE);
constexpr int KVP = N_HEADS * (QK_NOPE + V_HEAD);
constexpr int CONV_K = 31, CONV_IN = 3 * D_MODEL;
constexpr float RMS_EPS = 1e-6f, LN_EPS = 1e-5f;

namespace pg8 {
#define PG8_LAS __attribute__((address_space(3)))
typedef unsigned short bf16_t;
typedef short bf16x8 __attribute__((ext_vector_type(8)));
typedef float f32x4 __attribute__((ext_vector_type(4)));
typedef unsigned u32x4 __attribute__((ext_vector_type(4)));
typedef unsigned u32x2 __attribute__((ext_vector_type(2)));
constexpr int BM = 256, BK = 64, HALF = 128, HTB = HALF * BK * 2  , STAGE_BYTES = 8 * HTB, NXCD = 8, WGM = 8;

__host__ __device__ __forceinline__ int lds_byte(int r, int c) { const int st = (r >> 4) * 2 + (c >> 5), rr = r & 15, cc = c & 31, ob = rr * 64 + cc * 2; return st * 1024 + (ob ^ (((ob >> 9) & 1) << 5)); }
__host__ __device__ __forceinline__ void stage_rc(int b, int& R, int& C) { const int st = b / 1024, sb = b % 1024, swz = sb ^ (((sb >> 9) & 1) << 5); R = (st >> 1) * 16 + swz / 64; C = (st & 1) * 32 + (swz % 64) / 2; }
__host__ __device__ __forceinline__ int perm32(int rho) { const int n = rho >> 4, i = rho & 15; return 8 * (i >> 2) + 4 * n + (i & 3); }

struct Unit { int pm, pn; };
struct Gemm { const bf16_t* A; const bf16_t* Bt; int M, N, K, lda; };

struct StaticOrder {
    int nM, nN, nwg, G, c;
    __host__ __device__ void init(int M, int N, int G_, int c_) { nM = M / BM; nN = N / BM; nwg = nM * nN; G = G_; c = c_; }
    __host__ __device__ bool next(int i, Unit& u) const {
        const long L = (long)i * G + c; if (L >= nwg) return false;
        int wgid = (int)L; { const int q = nwg / NXCD, r = nwg % NXCD, xcd = wgid % NXCD, off = wgid / NXCD; wgid = (xcd < r ? xcd * (q + 1) : r * (q + 1) + (xcd - r) * q) + off; }
        const int nig = WGM * nN, gid = wgid / nig, fm = gid * WGM, gsz = (nM - fm) < WGM ? (nM - fm) : WGM;
        u.pm = fm + ((wgid % nig) % gsz); u.pn = (wgid % nig) / gsz; return true;
    }
    __device__ __forceinline__ void a_ready(const Unit&) const {}
    __device__ __forceinline__ void done(const Unit&) const {}
};

__device__ __forceinline__ unsigned cvt_pk_bf16(float lo, float hi) { unsigned r; asm volatile("v_cvt_pk_bf16_f32 %0, %1, %2" : "=v"(r) : "v"(lo), "v"(hi)); return r; }
__device__ __forceinline__ int opaque(int x) { asm volatile("" : "+v"(x)); return x; }
__device__ __forceinline__ float sigmoid_f(float v) { return __builtin_amdgcn_rcpf(1.f + __builtin_amdgcn_exp2f(-1.4426950408889634f * v)); }
__device__ __forceinline__ float silu_f(float v) { return v * sigmoid_f(v); }
__device__ __forceinline__ u32x4 pack8(const f32x4& a, const f32x4& b) { u32x4 w; w.x = cvt_pk_bf16(a[0], a[1]); w.y = cvt_pk_bf16(a[2], a[3]); w.z = cvt_pk_bf16(b[0], b[1]); w.w = cvt_pk_bf16(b[2], b[3]); return w; }
__device__ __forceinline__ float sumsq8(const f32x4& a, const f32x4& b) { return ((a[0] * a[0] + a[1] * a[1]) + (a[2] * a[2] + a[3] * a[3])) + ((b[0] * b[0] + b[1] * b[1]) + (b[2] * b[2] + b[3] * b[3])); }
__device__ __forceinline__ void rope8(f32x4& v0, f32x4& v1, const float* cs, const float* sn, size_t grow, int i0) {
    const f32x4 c = *(const f32x4*)(cs + grow * 32 + i0), s = *(const f32x4*)(sn + grow * 32 + i0);
    const f32x4 a = v0, b = v1;
    v0[0] = a[0] * c[0] - a[1] * s[0]; v0[1] = a[1] * c[0] + a[0] * s[0];
    v0[2] = a[2] * c[1] - a[3] * s[1]; v0[3] = a[3] * c[1] + a[2] * s[1];
    v1[0] = b[0] * c[2] - b[1] * s[2]; v1[1] = b[1] * c[2] + b[0] * s[2];
    v1[2] = b[2] * c[3] - b[3] * s[3]; v1[3] = b[3] * c[3] + b[2] * s[3];
}

template <int NP>
__device__ __forceinline__ void row_rstd8(float (&rstd)[8], const float* ssq, int stride, int off, int row0, float inv_n, float eps) {
    f32x4 p[8][NP / 4];
#pragma unroll
    for (int i = 0; i < 8; ++i)
#pragma unroll
        for (int q = 0; q < NP / 4; ++q) p[i][q] = *(const f32x4*)(ssq + (size_t)(row0 + (i >> 2) * HALF + (i & 3) * 16) * stride + off + 4 * q);
#pragma unroll
    for (int i = 0; i < 8; ++i) { float s = 0.f;
#pragma unroll
        for (int q = 0; q < NP / 4; ++q) s += (p[i][q][0] + p[i][q][1]) + (p[i][q][2] + p[i][q][3]);
        rstd[i] = rsqrtf(s * inv_n + eps); }
}

struct EpiMlaIn {
    static constexpr bool PERM = true, AFTER_DRAIN = false;
    bf16_t* Z; bf16_t* GO; const float* ssqx; float* ssql; const float* cs; const float* sn;
    __device__ __forceinline__ void operator()(const f32x4 (&acc)[2][2][4][2], const Unit& u, int wr, int wc, int fr_, int fq_) const {
        const int lane_ = opaque((int)(threadIdx.x & 63)), fr = lane_ & 15, fq = lane_ >> 4;
        const int pn = u.pn;
        float rs8[8]; row_rstd8<4>(rs8, ssqx, 4, 0, u.pm * BM + wr * 64 + fr, 1.0f / 1024.0f, RMS_EPS);
#pragma unroll
        for (int ai = 0; ai < 2; ++ai)
#pragma unroll
            for (int m = 0; m < 4; ++m) {
                const size_t grow = (size_t)(u.pm * BM + ai * HALF + wr * 64 + m * 16 + fr);
                const float rstd = rs8[ai * 4 + m];
                float s = 0.f;
#pragma unroll
                for (int bj = 0; bj < 2; ++bj) {
                    f32x4 v0 = acc[ai][bj][m][0] * rstd, v1 = acc[ai][bj][m][1] * rstd;
                    const int col0 = pn * BM + bj * HALF + wc * 32 + 8 * fq;
                    bf16_t* dst = Z + grow * ZP + col0;
                    if (pn >= 3) {
#pragma unroll
                        for (int j = 0; j < 4; ++j) { v0[j] = silu_f(v0[j]); v1[j] = silu_f(v1[j]); }
                        *(u32x4*)(GO + grow * 1024 + (col0 - Z_GATE)) = pack8(v0, v1);
                    } else if (pn == 1 && bj == 1) {
                        if (wc < 2) { rope8(v0, v1, cs, sn, grow, 16 * wc + 4 * fq); *(u32x4*)dst = pack8(v0, v1); }
                    } else { s += sumsq8(v0, v1); *(u32x4*)dst = pack8(v0, v1); }
                }
                if (pn <= 2) { s += __shfl_xor(s, 16); s += __shfl_xor(s, 32); if (fq == 0) ssql[grow * 12 + pn * 4 + wc] = s; }
                if (m & 1) asm volatile("" ::: "memory");
            }
    }
};
struct EpiQ {
    static constexpr bool PERM = true, AFTER_DRAIN = false;
    bf16_t* Q; const float* ssql; const float* cs; const float* sn;
    __device__ __forceinline__ void operator()(const f32x4 (&acc)[2][2][4][2], const Unit& u, int wr, int wc, int fr_, int fq_) const {
        const int lane_ = opaque((int)(threadIdx.x & 63)), fr = lane_ & 15, fq = lane_ >> 4;
        float rs8[8]; row_rstd8<8>(rs8, ssql, 12, 0, u.pm * BM + wr * 64 + fr, 1.0f / 384.0f, RMS_EPS);
#pragma unroll
        for (int ai = 0; ai < 2; ++ai)
#pragma unroll
            for (int m = 0; m < 4; ++m) {
                const size_t grow = (size_t)(u.pm * BM + ai * HALF + wr * 64 + m * 16 + fr);
                const float rstd = rs8[ai * 4 + m];
#pragma unroll
                for (int bj = 0; bj < 2; ++bj) {
                    f32x4 v0 = acc[ai][bj][m][0] * rstd, v1 = acc[ai][bj][m][1] * rstd;
                    const int cw = u.pn * BM + bj * HALF + wc * 32, hd = cw % 192, col0 = cw + 8 * fq;
                    if (hd >= 128) rope8(v0, v1, cs, sn, grow, ((hd - 128) >> 1) + 4 * fq);
                    *(u32x4*)(Q + grow * QP + col0) = pack8(v0, v1);
                }
                asm volatile("" ::: "memory");
            }
    }
};
struct EpiKV {
    static constexpr bool PERM = true, AFTER_DRAIN = false;
    bf16_t* KV; const float* ssql;
    __device__ __forceinline__ void operator()(const f32x4 (&acc)[2][2][4][2], const Unit& u, int wr, int wc, int fr_, int fq_) const {
        const int lane_ = opaque((int)(threadIdx.x & 63)), fr = lane_ & 15, fq = lane_ >> 4;
        float rs8[8]; row_rstd8<4>(rs8, ssql, 12, 8, u.pm * BM + wr * 64 + fr, 1.0f / 256.0f, RMS_EPS);
#pragma unroll
        for (int ai = 0; ai < 2; ++ai)
#pragma unroll
            for (int m = 0; m < 4; ++m) {
                const size_t grow = (size_t)(u.pm * BM + ai * HALF + wr * 64 + m * 16 + fr);
                const float rstd = rs8[ai * 4 + m];
#pragma unroll
                for (int bj = 0; bj < 2; ++bj) {
                    const f32x4 v0 = acc[ai][bj][m][0] * rstd, v1 = acc[ai][bj][m][1] * rstd;
                    const int col0 = u.pn * BM + bj * HALF + wc * 32 + 8 * fq;
                    *(u32x4*)(KV + grow * KVP + col0) = pack8(v0, v1);
                }
                if (m & 1) asm volatile("" ::: "memory");
            }
    }
};
struct EpiConvIn {
    static constexpr bool PERM = true, AFTER_DRAIN = false;
    bf16_t* U; bf16_t* G; const float* ssqx; const float* bias;
    __device__ __forceinline__ void operator()(const f32x4 (&acc)[2][2][4][2], const Unit& u, int wr, int wc, int fr_, int fq_) const {
        const int lane_ = opaque((int)(threadIdx.x & 63)), fr = lane_ & 15, fq = lane_ >> 4;
        const int pn = u.pn;
        float rs8[8]; row_rstd8<4>(rs8, ssqx, 4, 0, u.pm * BM + wr * 64 + fr, 1.0f / 1024.0f, RMS_EPS);
        f32x4 bA[2], bB[2];
#pragma unroll
        for (int bj = 0; bj < 2; ++bj) {
            if (pn < 8) { const int c0 = pn * 128 + bj * 64 + wc * 16 + 4 * fq; bA[bj] = *(const f32x4*)(bias + c0); bB[bj] = *(const f32x4*)(bias + 1024 + c0); }
            else { const int c0 = (pn - 8) * BM + bj * HALF + wc * 32 + 8 * fq; bA[bj] = *(const f32x4*)(bias + 2048 + c0); bB[bj] = *(const f32x4*)(bias + 2048 + c0 + 4); } }
#pragma unroll
        for (int ai = 0; ai < 2; ++ai)
#pragma unroll
            for (int m = 0; m < 4; ++m) {
                const size_t grow = (size_t)(u.pm * BM + ai * HALF + wr * 64 + m * 16 + fr);
                const float rstd = rs8[ai * 4 + m];
#pragma unroll
                for (int bj = 0; bj < 2; ++bj) {
                    f32x4 v0 = acc[ai][bj][m][0] * rstd, v1 = acc[ai][bj][m][1] * rstd;
                    if (pn < 8) {
                        const int c0 = pn * 128 + bj * 64 + wc * 16 + 4 * fq;
                        const f32x4 ba = bA[bj], bb = bB[bj];
                        const float u0 = (v0[0] + ba[0]) * sigmoid_f(v0[1] + bb[0]), u1 = (v0[2] + ba[1]) * sigmoid_f(v0[3] + bb[1]);
                        const float u2 = (v1[0] + ba[2]) * sigmoid_f(v1[1] + bb[2]), u3 = (v1[2] + ba[3]) * sigmoid_f(v1[3] + bb[3]);
                        u32x2 w; w.x = cvt_pk_bf16(u0, u1); w.y = cvt_pk_bf16(u2, u3);
                        *(u32x2*)(U + grow * 1024 + c0) = w;
                    } else {
                        const int c0 = (pn - 8) * BM + bj * HALF + wc * 32 + 8 * fq;
                        const f32x4 b0 = bA[bj], b1 = bB[bj];
#pragma unroll
                        for (int j = 0; j < 4; ++j) { v0[j] = silu_f(v0[j] + b0[j]); v1[j] = silu_f(v1[j] + b1[j]); }
                        *(u32x4*)(G + grow * 1024 + c0) = pack8(v0, v1);
                    }
                }
                if (m & 1) asm volatile("" ::: "memory");
            }
    }
};
struct EpiResid {
    static constexpr bool PERM = true, AFTER_DRAIN = true;
    const bf16_t* xin; bf16_t* xbo; float* xf32; float* ssq; const float* bias;
    __device__ __forceinline__ void fused(f32x4 (&acc)[2][2][4][2], const Unit& u, int wr, int wc, int fr_, int fq_, PG8_LAS unsigned char* lds, int wid, int lane) const {
        const int lane_ = opaque(lane), fr = lane_ & 15, fq = lane_ >> 4;
        PG8_LAS float* P = (PG8_LAS float*)lds;
        u32x4 xr[2][4][2];
#pragma unroll
        for (int ai = 0; ai < 2; ++ai)
#pragma unroll
            for (int m = 0; m < 4; ++m)
#pragma unroll
                for (int bj = 0; bj < 2; ++bj) xr[ai][m][bj] = *(const u32x4*)(xin + (size_t)(u.pm * BM + ai * HALF + wr * 64 + m * 16 + fr) * 1024 + u.pn * BM + bj * HALF + wc * 32 + 8 * fq);
        asm volatile("" ::: "memory");
#pragma unroll
        for (int ai = 0; ai < 2; ++ai)
#pragma unroll
            for (int m = 0; m < 4; ++m) {
                const int rt = ai * HALF + wr * 64 + m * 16 + fr;
                const size_t grow = (size_t)(u.pm * BM + rt);
                float s = 0.f;
#pragma unroll
                for (int bj = 0; bj < 2; ++bj) {
                    const int col0 = u.pn * BM + bj * HALF + wc * 32 + 8 * fq;
                    const u32x4 xo = xr[ai][m][bj];
                    f32x4 v0 = acc[ai][bj][m][0], v1 = acc[ai][bj][m][1];
                    v0[0] += __uint_as_float(xo[0] << 16); v0[1] += __uint_as_float(xo[0] & 0xffff0000u); v0[2] += __uint_as_float(xo[1] << 16); v0[3] += __uint_as_float(xo[1] & 0xffff0000u);
                    v1[0] += __uint_as_float(xo[2] << 16); v1[1] += __uint_as_float(xo[2] & 0xffff0000u); v1[2] += __uint_as_float(xo[3] << 16); v1[3] += __uint_as_float(xo[3] & 0xffff0000u);
                    if (bias) { v0 += *(const f32x4*)(bias + col0); v1 += *(const f32x4*)(bias + col0 + 4); }
                    if (xf32) { *(f32x4*)(xf32 + grow * 1024 + col0) = v0; *(f32x4*)(xf32 + grow * 1024 + col0 + 4) = v1; }
                    *(u32x4*)(xbo + grow * 1024 + col0) = pack8(v0, v1);
                    s += sumsq8(v0, v1);
                }
                s += __shfl_xor(s, 16); s += __shfl_xor(s, 32);
                if (fq == 0) P[rt * 4 + wc] = s;
                if (m & 1) asm volatile("" ::: "memory");
            }
        asm volatile("s_waitcnt lgkmcnt(0)" ::: "memory"); __builtin_amdgcn_s_barrier(); asm volatile("" ::: "memory");
        const int t = wid * 64 + lane;
        if (t < 256) { const PG8_LAS f32x4* p4 = (const PG8_LAS f32x4*)P; const f32x4 p = p4[t]; ssq[(size_t)(u.pm * BM + t) * 4 + u.pn] = (p[0] + p[1]) + (p[2] + p[3]); }
        asm volatile("s_waitcnt lgkmcnt(0)" ::: "memory"); __builtin_amdgcn_s_barrier(); asm volatile("" ::: "memory");
    }
};

__device__ __forceinline__ f32x4 zero4() { float z = 0.f; asm volatile("" : "+v"(z)); return (f32x4){z, z, z, z}; }
template <class Epi, class Sched, bool ALIGN_EPI = false, bool SP2 = false>
__device__ __forceinline__ void gemm_phase(PG8_LAS unsigned char* lds, const Gemm g, const Sched& S, const Epi& E) {
    const int tid = opaque((int)threadIdx.x), wid = __builtin_amdgcn_readfirstlane(tid >> 6), lane = tid & 63, wr = wid >> 2, wc = wid & 3, fr = lane & 15, fq = lane >> 4;
    const int K = g.K, nt = K / BK, lda = g.lda;
    unsigned voffA[2], voffB[2];
#pragma unroll
    for (int i = 0; i < 2; ++i) { int R, C; stage_rc(tid * 16 + i * 8192, R, C); const int Rb = Epi::PERM ? ((R & ~31) + perm32(R & 31)) : R;
        voffA[i] = (unsigned)(R * lda + C) * 2u; voffB[i] = (unsigned)(Rb * K + C) * 2u; }
    const size_t kstep = (size_t)(BK * 2);
    const size_t hstepA = (size_t)HALF * lda * 2, hstepB = (size_t)HALF * K * 2;
    const size_t tstepA = 2 * hstepA, tstepB = 2 * hstepB;
    const unsigned ldsw = (unsigned)wid * 1024u;
    const int aoff = lds_byte(wr * 64 + fr, fq * 8), boff = lds_byte(wc * 32 + fr, fq * 8);
#define PG8_SA(b, h) (((b) * 2 + (h)) * HTB)
#define PG8_SB(b, h) ((4 + (b) * 2 + (h)) * HTB)
#define PG8_STAGE(bufoff, gbase, voff) do { _Pragma("unroll") for (int _i = 0; _i < 2; ++_i) \
        __builtin_amdgcn_global_load_lds((const unsigned*)((const char*)(gbase) + (voff)[_i]), (PG8_LAS unsigned*)(lds + (bufoff) + ldsw + _i * 8192), 16, 0, 0); } while (0)
#define PG8_LDA(dst, b, h) do { _Pragma("unroll") for (int m = 0; m < 4; ++m) _Pragma("unroll") for (int k = 0; k < 2; ++k) dst[m][k] = *(const PG8_LAS bf16x8*)(lds + PG8_SA(b, h) + aoff + m * 2048 + k * 1024); } while (0)
#define PG8_LDB(dst, b, h) do { _Pragma("unroll") for (int n = 0; n < 2; ++n) _Pragma("unroll") for (int k = 0; k < 2; ++k) dst[n][k] = *(const PG8_LAS bf16x8*)(lds + PG8_SB(b, h) + boff + n * 2048 + k * 1024); } while (0)
#define PG8_MMA(ai, bj, At, Bt) do { __builtin_amdgcn_s_setprio(1); _Pragma("unroll") for (int m = 0; m < 4; ++m) _Pragma("unroll") for (int n = 0; n < 2; ++n) _Pragma("unroll") for (int k = 0; k < 2; ++k) \
        acc[ai][bj][m][n] = __builtin_amdgcn_mfma_f32_16x16x32_bf16(Bt[n][k], At[m][k], acc[ai][bj][m][n], 0, 0, 0); __builtin_amdgcn_s_setprio(0); } while (0)
#define PG8_WAIT_V(n) asm volatile("s_waitcnt vmcnt(" #n ")" ::: "memory")
#define PG8_WAIT_L(n) asm volatile("s_waitcnt lgkmcnt(" #n ")" ::: "memory")
#define PG8_BAR __builtin_amdgcn_s_barrier()
#define PG8_SCHED __builtin_amdgcn_sched_barrier(0)
    Unit cur, nxt; int ui = 0;
    if (!S.next(0, cur)) return;
    f32x4 acc[2][2][4][2];
#pragma unroll
    for (int a = 0; a < 2; ++a)
#pragma unroll
        for (int b = 0; b < 2; ++b)
#pragma unroll
            for (int m = 0; m < 4; ++m)
#pragma unroll
                for (int n = 0; n < 2; ++n) acc[a][b][m][n] = zero4();
    bf16x8 At[4][2] = {}, B0[2][2] = {}, B1[2][2] = {};
    const char* cA = (const char*)g.A + (size_t)cur.pm * tstepA; const char* cB = (const char*)g.Bt + (size_t)cur.pn * tstepB;
    S.a_ready(cur);
    if constexpr (SP2) {
        PG8_STAGE(PG8_SB(0, 0), cB, voffB); PG8_STAGE(PG8_SB(0, 1), cB + hstepB, voffB); PG8_STAGE(PG8_SA(0, 0), cA, voffA); PG8_STAGE(PG8_SA(0, 1), cA + hstepA, voffA);
        if (wr == 1) PG8_BAR;
        PG8_WAIT_V(2); PG8_BAR;
        PG8_STAGE(PG8_SB(1, 0), cB + kstep, voffB); PG8_STAGE(PG8_SA(1, 0), cA + kstep, voffA); PG8_STAGE(PG8_SB(1, 1), cB + hstepB + kstep, voffB);
        PG8_WAIT_V(6); PG8_BAR;
    } else {
        PG8_STAGE(PG8_SB(0, 0), cB, voffB); PG8_STAGE(PG8_SA(0, 0), cA, voffA); PG8_STAGE(PG8_SB(0, 1), cB + hstepB, voffB); PG8_STAGE(PG8_SA(0, 1), cA + hstepA, voffA);
        if (wr == 1) PG8_BAR;
        PG8_WAIT_V(4); PG8_BAR;
        PG8_STAGE(PG8_SB(1, 0), cB + kstep, voffB); PG8_STAGE(PG8_SA(1, 0), cA + kstep, voffA); PG8_STAGE(PG8_SB(1, 1), cB + hstepB + kstep, voffB);
        PG8_WAIT_V(6); PG8_BAR;
    }
    for (;;) {
        const bool has_next = S.next(ui + 1, nxt);
        const char* nA = has_next ? (const char*)g.A + (size_t)nxt.pm * tstepA : cA; const char* nB = has_next ? (const char*)g.Bt + (size_t)nxt.pn * tstepB : cB;
#pragma nounroll
        for (int t = 0; t < nt; t += 2) {
            const bool last = (t == nt - 2);
            const char* a1 = cA + (size_t)(t + 1) * kstep;
            const char* a2 = last ? nA : cA + (size_t)(t + 2) * kstep; const char* b2 = last ? nB : cB + (size_t)(t + 2) * kstep;
            const char* a3 = a2 + kstep; const char* b3 = b2 + kstep;
            if (last && has_next) S.a_ready(nxt);
            if constexpr (SP2) {
            PG8_LDB(B0, 0, 0); PG8_LDB(B1, 0, 1); PG8_SCHED; PG8_LDA(At, 0, 0); PG8_STAGE(PG8_SA(1, 1), a1 + hstepA, voffA);
            PG8_WAIT_V(8); PG8_WAIT_L(0); PG8_BAR; PG8_MMA(0, 0, At, B0); PG8_MMA(0, 1, At, B1); PG8_BAR; PG8_SCHED;
            PG8_LDA(At, 0, 1); PG8_STAGE(PG8_SB(0, 0), b2, voffB); PG8_STAGE(PG8_SB(0, 1), b2 + hstepB, voffB); PG8_STAGE(PG8_SA(0, 0), a2, voffA);
            PG8_WAIT_V(8); PG8_WAIT_L(0); PG8_BAR; PG8_MMA(1, 0, At, B0); PG8_MMA(1, 1, At, B1); PG8_BAR; PG8_SCHED;
            PG8_LDB(B0, 1, 0); PG8_LDB(B1, 1, 1); PG8_SCHED; PG8_LDA(At, 1, 0); PG8_STAGE(PG8_SA(0, 1), a2 + hstepA, voffA);
            PG8_WAIT_V(8); PG8_WAIT_L(0); PG8_BAR; PG8_MMA(0, 0, At, B0); PG8_MMA(0, 1, At, B1); PG8_BAR; PG8_SCHED;
            PG8_LDA(At, 1, 1); PG8_STAGE(PG8_SB(1, 0), b3, voffB); PG8_STAGE(PG8_SB(1, 1), b3 + hstepB, voffB); PG8_STAGE(PG8_SA(1, 0), a3, voffA);
            PG8_WAIT_V(8); PG8_WAIT_L(0); PG8_BAR; PG8_MMA(1, 0, At, B0); PG8_MMA(1, 1, At, B1); PG8_BAR; PG8_SCHED;
            } else {
            PG8_LDB(B0, 0, 0); PG8_SCHED; PG8_LDA(At, 0, 0); PG8_STAGE(PG8_SA(1, 1), a1 + hstepA, voffA);
            PG8_WAIT_L(8); PG8_BAR; PG8_WAIT_L(0); PG8_MMA(0, 0, At, B0); PG8_BAR; PG8_SCHED;
            PG8_LDB(B1, 0, 1); PG8_STAGE(PG8_SB(0, 0), b2, voffB);
            PG8_BAR; PG8_WAIT_L(0); PG8_MMA(0, 1, At, B1); PG8_BAR;
            PG8_LDA(At, 0, 1); PG8_STAGE(PG8_SA(0, 0), a2, voffA);
            PG8_BAR; PG8_WAIT_L(0); PG8_MMA(1, 0, At, B0); PG8_BAR; PG8_SCHED;
            PG8_STAGE(PG8_SB(0, 1), b2 + hstepB, voffB);
            PG8_WAIT_V(6); PG8_BAR; PG8_MMA(1, 1, At, B1); PG8_BAR;
            PG8_LDB(B0, 1, 0); PG8_SCHED; PG8_LDA(At, 1, 0); PG8_STAGE(PG8_SA(0, 1), a2 + hstepA, voffA);
            PG8_WAIT_L(8); PG8_BAR; PG8_WAIT_L(0); PG8_MMA(0, 0, At, B0); PG8_BAR; PG8_SCHED;
            PG8_LDB(B1, 1, 1); PG8_STAGE(PG8_SB(1, 0), b3, voffB);
            PG8_BAR; PG8_WAIT_L(0); PG8_MMA(0, 1, At, B1); PG8_BAR;
            PG8_LDA(At, 1, 1); PG8_STAGE(PG8_SA(1, 0), a3, voffA);
            PG8_BAR; PG8_WAIT_L(0); PG8_MMA(1, 0, At, B0); PG8_BAR; PG8_SCHED;
            PG8_STAGE(PG8_SB(1, 1), b3 + hstepB, voffB);
            PG8_WAIT_V(6); PG8_BAR; PG8_MMA(1, 1, At, B1); PG8_BAR;
            }
        }
        if constexpr (ALIGN_EPI) { if (wr == 0) PG8_BAR; }
        if constexpr (!Epi::AFTER_DRAIN) { E(acc, cur, wr, wc, fr, fq); S.done(cur); }
        if (!has_next) break;
#pragma unroll
        for (int a = 0; a < 2; ++a)
#pragma unroll
            for (int b = 0; b < 2; ++b)
#pragma unroll
                for (int m = 0; m < 4; ++m)
#pragma unroll
                    for (int n = 0; n < 2; ++n) acc[a][b][m][n] = zero4();
        cur = nxt; cA = nA; cB = nB; ++ui;
        if constexpr (ALIGN_EPI) { if (wr == 1) PG8_BAR; }
    }
    PG8_WAIT_V(0);
    if constexpr (!ALIGN_EPI) { if (wr == 0) PG8_BAR; }
    PG8_BAR;
    if constexpr (Epi::AFTER_DRAIN) { E.fused(acc, cur, wr, wc, fr, fq, lds, wid, lane); S.done(cur); }
#undef PG8_SA
#undef PG8_SB
#undef PG8_STAGE
#undef PG8_LDA
#undef PG8_LDB
#undef PG8_MMA
#undef PG8_WAIT_V
#undef PG8_WAIT_L
#undef PG8_BAR
#undef PG8_SCHED
}
}

namespace attn {
using bf16 = __hip_bfloat16;
typedef short bf16x8 __attribute__((ext_vector_type(8)));
typedef short s16x4 __attribute__((ext_vector_type(4)));
typedef float f32x16 __attribute__((ext_vector_type(16)));
typedef float f32x4 __attribute__((ext_vector_type(4)));
typedef unsigned u32x4 __attribute__((ext_vector_type(4)));
constexpr int D = 128, DQK = 192;
constexpr float THR = 8.f;
constexpr float SCALE = 0.07216878364870322f;
constexpr int NW = 8, QBLK = 32, KVBLK = 64, QB = NW * QBLK;
constexpr int SHM_V = KVBLK * D * 2, SHM_K = KVBLK * D * 2, SHM_KP = KVBLK * 64 * 2;
constexpr int OFF_K = 2 * SHM_V, OFF_KP = OFF_K + 2 * SHM_K, OFF_WS = OFF_KP + 2 * SHM_KP, OFF_OST = OFF_WS + NW * 64 * 4, LDS_BYTES = OFF_OST + NW * 8192;
constexpr int NQD = DQK / 16;

#define KSWZ(row, colB) ((row) * 256 + ((colB) ^ (((row) & 7) << 4)))
#define SBAR() __builtin_amdgcn_sched_barrier(0)
__device__ __forceinline__ int v_st(int k, int c) { const int kk = (k & ~0xC) | ((k & 4) << 1) | ((k & 8) >> 1); return ((kk >> 3) * 4 + (c >> 5)) * 512 + ((kk & 7) * 32 + (c & 31)) * 2; }
__device__ __forceinline__ int v_rd_base(int lane) { return ((lane & 3) << 3) | (((lane >> 2) & 3) << 6) | (((lane >> 4) & 1) << 5) | (((lane >> 5) & 1) << 8); }
constexpr int v_rd_off(int d0, int ks, int half) { return d0 * 512 + ks * 4096 + half * 2048; }
__device__ __forceinline__ int crow(int r, int hi) { return (r & 3) + 8 * (r >> 2) + 4 * hi; }
__device__ __forceinline__ unsigned cvtpk(float lo, float hi) { unsigned r; asm volatile("v_cvt_pk_bf16_f32 %0, %1, %2" : "=v"(r) : "v"(lo), "v"(hi)); return r; }
__device__ __forceinline__ int opaque(int x) { asm volatile("" : "+v"(x)); return x; }
__device__ __forceinline__ bf16x8 load8(const bf16* p) { return *reinterpret_cast<const bf16x8*>(p); }
__device__ __forceinline__ void mask_tile(f32x16& p0, f32x16& p1, int dq) {
    const float NEG = -__builtin_inff();
#pragma unroll
    for (int r = 0; r < 16; ++r) {
        const int c = (r & 3) + 8 * (r >> 2);
        if (dq - c < 0) p0[r] = NEG;
        if (dq - c - 32 < 0) p1[r] = NEG;
    }
}
__device__ __forceinline__ void partialSM(f32x16& p0, f32x16& p1, float& m_reg, float& mn, float& alpha) {
    float pmax = p0[0];
#pragma unroll
    for (int r = 1; r < 16; ++r) pmax = fmaxf(pmax, p0[r]);
#pragma unroll
    for (int r = 0; r < 16; ++r) pmax = fmaxf(pmax, p1[r]);
    { auto rr = __builtin_amdgcn_permlane32_swap(__float_as_uint(pmax), __float_as_uint(pmax), false, false);
      pmax = fmaxf(__uint_as_float(rr[0]), __uint_as_float(rr[1])); }
    constexpr float C2 = 1.4426950408889634f * SCALE;
    if (__builtin_expect(__all((pmax - m_reg) * SCALE <= THR), 1)) { mn = m_reg; alpha = 1.f; }
    else { mn = fmaxf(m_reg, pmax); alpha = __builtin_amdgcn_exp2f((m_reg - mn) * C2); m_reg = mn; }
    const float mnL = -mn * C2;
#pragma unroll
    for (int r = 0; r < 16; ++r) p0[r] = fmaf(p0[r], C2, mnL);
#pragma unroll
    for (int r = 0; r < 16; ++r) p1[r] = fmaf(p1[r], C2, mnL);
#pragma unroll
    for (int r = 0; r < 16; ++r) p0[r] = __builtin_amdgcn_exp2f(p0[r]);
}
__device__ __forceinline__ void finishSM(f32x16& p0, f32x16& p1, float alpha, float& l_reg, bf16x8& pa0, bf16x8& pa1, bf16x8& pa2, bf16x8& pa3) {
#pragma unroll
    for (int r = 0; r < 16; ++r) p1[r] = __builtin_amdgcn_exp2f(p1[r]);
    float ps = 0;
#pragma unroll
    for (int r = 0; r < 16; ++r) ps += p0[r];
#pragma unroll
    for (int r = 0; r < 16; ++r) ps += p1[r];
    { auto rr = __builtin_amdgcn_permlane32_swap(__float_as_uint(ps), __float_as_uint(ps), false, false);
      ps = __uint_as_float(rr[0]) + __uint_as_float(rr[1]); }
    l_reg = l_reg * alpha + ps;
#define PK4(P, B_, OUT) do { unsigned a0 = cvtpk(P[B_+0], P[B_+1]), a1 = cvtpk(P[B_+2], P[B_+3]);                          \
        unsigned b0 = cvtpk(P[B_+4], P[B_+5]), b1 = cvtpk(P[B_+6], P[B_+7]);                                             \
        auto r0 = __builtin_amdgcn_permlane32_swap(a0, b0, false, false); auto r1 = __builtin_amdgcn_permlane32_swap(a1, b1, false, false); \
        u32x4 w = {r0[0], r1[0], r0[1], r1[1]}; OUT = *reinterpret_cast<bf16x8*>(&w); } while (0)
    PK4(p0, 0, pa0); PK4(p0, 8, pa1); PK4(p1, 0, pa2); PK4(p1, 8, pa3);
#undef PK4
}
template <int KB>
__device__ __forceinline__ void qkt(f32x16& p0, f32x16& p1, const char* K_lds, int r32, int hi, const bf16x8* qr, const char* qpl) {
    p0 = f32x16{}; p1 = f32x16{};
    __builtin_amdgcn_s_setprio(1);
    const char* kb[4];
#pragma unroll
    for (int dd = 0; dd < 4; ++dd) kb[dd] = K_lds + KB * SHM_K + KSWZ(r32, (dd * 16 + hi * 8) * 2);
#pragma unroll
    for (int d0 = 0; d0 < 8; ++d0) { const char* a = kb[d0 & 3] + (d0 >> 2) * 128;
        bf16x8 b0 = *reinterpret_cast<const bf16x8*>(a);
        bf16x8 b1 = *reinterpret_cast<const bf16x8*>(a + 32 * 256);
        p0 = __builtin_amdgcn_mfma_f32_32x32x16_bf16(b0, qr[d0], p0, 0, 0, 0);
        p1 = __builtin_amdgcn_mfma_f32_32x32x16_bf16(b1, qr[d0], p1, 0, 0, 0); }
#pragma unroll
    for (int e = 0; e < 4; ++e) { const char* a = kb[e] + (2 * SHM_K - KB * SHM_K + KB * SHM_KP);
        bf16x8 b0 = *reinterpret_cast<const bf16x8*>(a);
        bf16x8 b1 = *reinterpret_cast<const bf16x8*>(a + 128);
        const bf16x8 qe = *reinterpret_cast<const bf16x8*>(qpl + e * 1024);
        p0 = __builtin_amdgcn_mfma_f32_32x32x16_bf16(b0, qe, p0, 0, 0, 0);
        p1 = __builtin_amdgcn_mfma_f32_32x32x16_bf16(b1, qe, p1, 0, 0, 0); }
    __builtin_amdgcn_s_setprio(0);
}
template <int VB>
__device__ __forceinline__ void pv_tile(f32x16* o, int vb0, bf16x8 pa0, bf16x8 pa1, bf16x8 pa2, bf16x8 pa3) {
#define TRRD(dst, off) asm volatile("ds_read_b64_tr_b16 %0, %1 offset:%2" : "=&v"(dst) : "v"(vb0), "i"(off) : "memory")
#define PV_D0(d0) do { s16x4 l0, l1, l2, l3, h0, h1, h2, h3; constexpr int b_ = VB * SHM_V + v_rd_off(d0, 0, 0);     \
        TRRD(l0, b_); TRRD(h0, b_ + 2048); TRRD(l1, b_ + 4096); TRRD(h1, b_ + 6144); TRRD(l2, b_ + 8192); TRRD(h2, b_ + 10240); TRRD(l3, b_ + 12288); TRRD(h3, b_ + 14336); \
        asm volatile("s_waitcnt lgkmcnt(0)" ::: "memory"); SBAR();                                                                  \
        o[d0] = __builtin_amdgcn_mfma_f32_32x32x16_bf16(pa0, (bf16x8){l0[0], l0[1], l0[2], l0[3], h0[0], h0[1], h0[2], h0[3]}, o[d0], 0, 0, 0);   \
        o[d0] = __builtin_amdgcn_mfma_f32_32x32x16_bf16(pa1, (bf16x8){l1[0], l1[1], l1[2], l1[3], h1[0], h1[1], h1[2], h1[3]}, o[d0], 0, 0, 0);   \
        o[d0] = __builtin_amdgcn_mfma_f32_32x32x16_bf16(pa2, (bf16x8){l2[0], l2[1], l2[2], l2[3], h2[0], h2[1], h2[2], h2[3]}, o[d0], 0, 0, 0);   \
        o[d0] = __builtin_amdgcn_mfma_f32_32x32x16_bf16(pa3, (bf16x8){l3[0], l3[1], l3[2], l3[3], h3[0], h3[1], h3[2], h3[3]}, o[d0], 0, 0, 0); } while (0)
    __builtin_amdgcn_s_setprio(1); PV_D0(0); PV_D0(1); PV_D0(2); PV_D0(3); __builtin_amdgcn_s_setprio(0);
#undef PV_D0
#undef TRRD
}

typedef __amdgpu_buffer_rsrc_t rsrc_t;
struct BlockRef { unsigned q, kn, kp, o; int P0; };
struct Seam { bf16x8 qr[8]; bf16x8 qpe[4]; bf16x8 st_v0, st_v1, st_k0, st_k1, st_kp; };
__device__ __forceinline__ bf16x8 bld8(rsrc_t r, unsigned voff, unsigned soff) { const u32x4 v = __builtin_amdgcn_raw_buffer_load_b128(r, voff, soff, 0); return __builtin_bit_cast(bf16x8, v); }
#define VMW() asm volatile("s_waitcnt vmcnt(0)" ::: "memory")
#define VMWN(n) asm volatile("s_waitcnt vmcnt(%0)" :: "i"(n) : "memory")
#define SLOAD(R, k0) do { const unsigned so_ = (R).kn + (unsigned)(k0) * (KVP * 2), sp_ = (R).kp + (unsigned)(k0) * (ZP * 2);                       \
                          S.st_v0 = bld8(rs, vkv + 256, so_); S.st_v1 = bld8(rs, vkv + 256, so_ + 32 * KVP * 2);                                   \
                          S.st_k0 = bld8(rs, vkv, so_); S.st_k1 = bld8(rs, vkv, so_ + 32 * KVP * 2);                                               \
                          S.st_kp = bld8(rs, vkp, sp_); } while (0)
#define QLOAD(R) do { _Pragma("unroll") for (int d0 = 0; d0 < 8; ++d0) S.qr[d0] = bld8(rs, vq + d0 * 32, (R).q); } while (0)
#define QPLOAD(R) do { _Pragma("unroll") for (int e = 0; e < 4; ++e) S.qpe[e] = bld8(rs, vq + (8 + e) * 32, (R).q); } while (0)
#define QPWRITE() do { _Pragma("unroll") for (int e = 0; e < 4; ++e) *(bf16x8*)(qpl + e * 1024) = S.qpe[e]; } while (0)
#define SWRITE_K(bf) do { *(bf16x8*)(K_lds + (bf) * SHM_K + kws) = S.st_k0; *(bf16x8*)(K_lds + (bf) * SHM_K + kws + 32 * 256) = S.st_k1; \
                          *(bf16x8*)(KP_lds + (bf) * SHM_KP + kpw) = S.st_kp; } while (0)
#define SWRITE_V(bf) do { *(bf16x8*)(V_lds + (bf) * SHM_V + vst0) = S.st_v0; *(bf16x8*)(V_lds + (bf) * SHM_V + vst1) = S.st_v1; } while (0)
#define SWRITE_ALL(bf) do { SWRITE_V(bf); SWRITE_K(bf); } while (0)
__device__ __forceinline__ void attn_prime(const BlockRef& cur, rsrc_t rs, char* lds, Seam& S) {
    const int tid = opaque(threadIdx.x), wid = __builtin_amdgcn_readfirstlane(tid >> 6), lane = tid & 63, r32 = lane & 31, hi = lane >> 5;
    const int sr = tid >> 4, sc = (tid & 15) * 8, kws = KSWZ(sr, sc * 2), pr = tid >> 3, pc = tid & 7, kpw = KSWZ(pr & 31, ((pr >> 5) * 8 + pc) * 16);
    const unsigned vq = (unsigned)((wid * QBLK + r32) * QP + hi * 8) * 2u, vkv = (unsigned)(sr * KVP + sc) * 2u, vkp = (unsigned)(pr * ZP + pc * 8) * 2u;
    char* K_lds = lds + OFF_K; char* KP_lds = lds + OFF_KP;
    char* qpl = lds + OFF_OST + wid * 8192 + lane * 16;
    QLOAD(cur); QPLOAD(cur);
    SLOAD(cur, 0); VMW(); SWRITE_K(0); QPWRITE();
    __syncthreads();
}
__device__ __forceinline__ void attn_block(const BlockRef& cur, const BlockRef& nxt, rsrc_t rs, char* lds, Seam& S) {
    const int tid = opaque(threadIdx.x), wid = __builtin_amdgcn_readfirstlane(tid >> 6), lane = tid & 63, r32 = lane & 31, hi = lane >> 5;
    const int NT = (cur.P0 + QB) / KVBLK;
    const int qlo = cur.P0 + wid * QBLK, qm = qlo + r32 - 4 * hi;
    char* V_lds = lds; char* K_lds = lds + OFF_K; char* KP_lds = lds + OFF_KP;
    float* ws = (float*)(lds + OFF_WS) + wid * 64; float* li_l = ws, * al_l = ws + 32;
    float m_reg = -1e30f, l_reg = 0; f32x16 o[4] = {};
    const int sr = tid >> 4, sc = (tid & 15) * 8, vst0 = v_st(sr, sc), vst1 = v_st(32 + sr, sc), kws = KSWZ(sr, sc * 2);
    const int pr = tid >> 3, pc = tid & 7, kpw = KSWZ(pr & 31, ((pr >> 5) * 8 + pc) * 16);
    const int vb0 = (int)(uintptr_t)V_lds + v_rd_base(lane);
    char* qpl = lds + OFF_OST + wid * 8192 + lane * 16;
    const unsigned vkv = (unsigned)(sr * KVP + sc) * 2u, vkp = (unsigned)(pr * ZP + pc * 8) * 2u;
#define RESC(a) do { if (__any((a) < 1.f)) { if (hi == 0) al_l[r32] = (a); asm volatile("s_waitcnt lgkmcnt(0)" ::: "memory");              \
                     for (int d_ = 0; d_ < 4; ++d_) for (int r = 0; r < 16; ++r) o[d_][r] *= al_l[crow(r, hi)]; } } while (0)
#define KBASE(t) ((t) * KVBLK)
#define MASKT(P0_, P1_, t) do { const int kb_ = KBASE(t); if (kb_ + KVBLK - 1 > qlo) mask_tile(P0_, P1_, qm - kb_); } while (0)
    f32x16 pA0, pA1, pB0, pB1; float mnA, mnB, alA, alB; bf16x8 pa0, pa1, pa2, pa3;
    SWRITE_V(0); SBAR();
    if (NT > 1) { SLOAD(cur, KBASE(1)); }
    SBAR(); qkt<0>(pA0, pA1, K_lds, r32, hi, S.qr, qpl);
    MASKT(pA0, pA1, 0); partialSM(pA0, pA1, m_reg, mnA, alA);
    if (NT > 1) { VMW(); SWRITE_ALL(1); }
    __syncthreads();
#define HALF_STEP(PX0, PX1, mnX, alX, PY0, PY1, alY, t, KB, VB, SB) do {                                                      \
        SBAR(); qkt<KB>(PX0, PX1, K_lds, r32, hi, S.qr, qpl);                                                                      \
        finishSM(PY0, PY1, alY, l_reg, pa0, pa1, pa2, pa3); SBAR();                                                           \
        if ((t) + 1 < NT) { SLOAD(cur, KBASE((t) + 1)); SBAR(); }                                                             \
        pv_tile<VB>(o, vb0, pa0, pa1, pa2, pa3); MASKT(PX0, PX1, (t)); partialSM(PX0, PX1, m_reg, mnX, alX);                  \
        __syncthreads();                                                                                                      \
        if ((t) + 1 < NT) { VMW(); SWRITE_ALL(SB); }                                                                          \
        RESC(alX); __syncthreads(); } while (0)
    for (int t = 1; t + 1 < NT; t += 2) {
        HALF_STEP(pB0, pB1, mnB, alB, pA0, pA1, alA, t, 1, 0, 0);
        HALF_STEP(pA0, pA1, mnA, alA, pB0, pB1, alB, t + 1, 0, 1, 1);
    }
    SBAR(); qkt<1>(pB0, pB1, K_lds, r32, hi, S.qr, qpl); SBAR();
    finishSM(pA0, pA1, alA, l_reg, pa0, pa1, pa2, pa3); SBAR();
    pv_tile<0>(o, vb0, pa0, pa1, pa2, pa3);
    SBAR(); { const int l2 = opaque(lane); const unsigned vq = (unsigned)((wid * QBLK + (l2 & 31)) * QP + (l2 >> 5) * 8) * 2u; QLOAD(nxt); } SLOAD(nxt, 0); SBAR();
    MASKT(pB0, pB1, NT - 1); partialSM(pB0, pB1, m_reg, mnB, alB); __syncthreads(); RESC(alB);
    finishSM(pB0, pB1, alB, l_reg, pa0, pa1, pa2, pa3); SBAR(); pv_tile<1>(o, vb0, pa0, pa1, pa2, pa3);
    SBAR(); { const int l2 = opaque(lane); const unsigned vq = (unsigned)((wid * QBLK + (l2 & 31)) * QP + (l2 >> 5) * 8) * 2u; QPLOAD(nxt); }
    SBAR(); VMWN(4); SWRITE_K(0); SBAR();
    if (hi == 0) li_l[r32] = l_reg; asm volatile("s_waitcnt lgkmcnt(0)" ::: "memory");
    float rli[16];
#pragma unroll
    for (int r = 0; r < 16; ++r) rli[r] = __builtin_amdgcn_rcpf(li_l[crow(r, hi)]);
    bf16* stg = (bf16*)(lds + OFF_OST) + wid * 4096;
#pragma unroll
    for (int r = 0; r < 16; ++r) { const int orow = crow(r, hi);
#pragma unroll
        for (int d0 = 0; d0 < 4; ++d0) stg[orow * 128 + d0 * 32 + r32] = __float2bfloat16(o[d0][r] * rli[r]); }
    asm volatile("s_waitcnt lgkmcnt(0)" ::: "memory");
    { const int l3 = opaque(lane); const unsigned vo = (unsigned)((wid * QBLK + (l3 >> 4)) * 1024 + (l3 & 15) * 8) * 2u;
#pragma unroll
    for (int i = 0; i < 8; ++i) { const int row = i * 4 + (l3 >> 4), ch = l3 & 15;
        const u32x4 ov = *(const u32x4*)(stg + row * 128 + ch * 8);
        const u32x4 gv = __builtin_amdgcn_raw_buffer_load_b128(rs, vo, cur.o + (unsigned)(i * 4 * 1024 * 2), 0);
        u32x4 w;
#pragma unroll
        for (int j = 0; j < 4; ++j) { const float olo = __uint_as_float(ov[j] << 16), ohi = __uint_as_float(ov[j] & 0xffff0000u), glo = __uint_as_float(gv[j] << 16), ghi = __uint_as_float(gv[j] & 0xffff0000u);
            w[j] = cvtpk(olo * glo, ohi * ghi); }
        __builtin_amdgcn_raw_buffer_store_b128(w, rs, vo, cur.o + (unsigned)(i * 4 * 1024 * 2), 0); } }
    asm volatile("s_waitcnt lgkmcnt(0)" ::: "memory"); QPWRITE();
    __syncthreads();
#undef RESC
#undef KBASE
#undef MASKT
#undef HALF_STEP
}
#undef VMW
#undef VMWN
#undef SLOAD
#undef QLOAD
#undef QPLOAD
#undef QPWRITE
#undef SWRITE_K
#undef SWRITE_V
#undef SWRITE_ALL
#undef KSWZ
#undef SBAR
}

constexpr int NWAVES = 8;
constexpr int NSTEPS = 16;
constexpr size_t MiB = 1u << 20;
constexpr size_t WS_CTL = 0, CTL_ZERO_BYTES = 64 * 1024;
constexpr size_t WS_SSQ = 1 * MiB, WS_SSQL = 1 * MiB + 256 * 1024;
constexpr size_t WS_W = 2 * MiB;
constexpr size_t SZ_WINM = (size_t)ZN * 1024 * 2, SZ_WQB = (size_t)QP * Q_LORA * 2, SZ_WKVB = (size_t)KVP * KV_LORA * 2, SZ_WO = (size_t)1024 * 1024 * 2, SZ_WINC = (size_t)CONV_IN * 1024 * 2;
constexpr size_t WS_WINM = WS_W, WS_WQB = WS_WINM + 2 * SZ_WINM, WS_WKVB = WS_WQB + 2 * SZ_WQB, WS_WOM = WS_WKVB + 2 * SZ_WKVB, WS_WINC = WS_WOM + 2 * SZ_WO, WS_WOC = WS_WINC + 2 * SZ_WINC;
static_assert(WS_WOC + 2 * SZ_WO <= 34 * MiB, "weights region");
constexpr size_t WS_COS = 34 * MiB, WS_SIN = 36 * MiB;
constexpr size_t WS_OA = 38 * MiB;
constexpr size_t WS_ZM = 70 * MiB;
constexpr size_t WS_XB = 94 * MiB;
constexpr size_t WS_Q = 126 * MiB, WS_U = 126 * MiB;
constexpr size_t WS_KV = 174 * MiB, WS_G = 174 * MiB;
constexpr size_t WS_END = 238 * MiB;
constexpr int CW_BAR = 1024;
constexpr int RING_OFF = 0, MISC_OFF = 149504, LDS_BYTES = 150 * 1024;
static_assert(attn::LDS_BYTES <= MISC_OFF && pg8::STAGE_BYTES <= MISC_OFF, "LDS map");

#define GAS __attribute__((address_space(1)))
#define LAS __attribute__((address_space(3)))
typedef unsigned short bf16u;
typedef unsigned v4u __attribute__((ext_vector_type(4)));
typedef float f32x4 __attribute__((ext_vector_type(4)));
typedef float f32x2 __attribute__((ext_vector_type(2)));
typedef GAS unsigned gu32;
#define RLX_AGENT __ATOMIC_RELAXED, __HIP_MEMORY_SCOPE_AGENT
#define LDS_WAIT() asm volatile("s_waitcnt lgkmcnt(0)" ::: "memory")
__device__ __forceinline__ unsigned f2bf(float f) { unsigned u = __builtin_bit_cast(unsigned, f); return (u + 0x7fffu + ((u >> 16) & 1u)) >> 16; }
__device__ __forceinline__ unsigned pk2(float lo, float hi) { return f2bf(lo) | (f2bf(hi) << 16); }

#define XB_TMO      128
#define XB_XCNT(j)  (256  + 64 * (j))
#define XB_XSUB(j)  (1280 + 64 * (j))
#define XB_XGEN(j)  (2304 + 64 * (j))
#define XB_TOP      3328
#define XB_TOPGEN   3392
#define XCD_BAR_WORDS 3456
#define XB_SPIN_CAP (1u << 18)
__device__ __forceinline__ unsigned xb_ld(unsigned* p)              { return __hip_atomic_load(p, __ATOMIC_RELAXED, __HIP_MEMORY_SCOPE_AGENT); }
__device__ __forceinline__ unsigned xb_add(unsigned* p, unsigned v) { return __hip_atomic_fetch_add(p, v, __ATOMIC_RELAXED, __HIP_MEMORY_SCOPE_AGENT); }
__device__ __forceinline__ unsigned xb_xcc_id() { return (unsigned)__builtin_amdgcn_s_getreg((3 << 11) | 20) & 0xFu; }
#define XB_SPIN(cond, bar) do { unsigned _sp = 0; while (cond) { __builtin_amdgcn_s_sleep(1); \
    if ((++_sp & 255u) == 0u) { if (xb_ld(&(bar)[XB_TMO])) break; if (_sp > XB_SPIN_CAP) { atomicAdd(&(bar)[XB_TMO], 1u); break; } } } } while (0)
struct XcdBarrier { unsigned* bar; unsigned x; volatile LAS unsigned* st; };
__device__ __forceinline__ XcdBarrier xcd_barrier_post(unsigned* bar, volatile LAS unsigned* st) {
    XcdBarrier b; b.bar = bar; b.x = xb_xcc_id(); b.st = st;
    if (threadIdx.x == 0) (void)xb_add(&bar[XB_XCNT(b.x)], 1u);
    return b;
}
__device__ __forceinline__ void xcd_barrier_complete(unsigned* bar, unsigned x, unsigned& nloc, unsigned& nx) {
    const unsigned G = gridDim.x * gridDim.y * gridDim.z;
    unsigned sum, cnt, mine, sp = 0u;
    for (;;) {
        sum = 0u; cnt = 0u; mine = 0u;
#pragma unroll
        for (unsigned j = 0; j < 16; ++j) { const unsigned c = xb_ld(&bar[XB_XCNT(j)]); sum += c; cnt += (c > 0u) ? 1u : 0u; mine = (j == x) ? c : mine; }
        if (sum == G) break;
        __builtin_amdgcn_s_sleep(1);
        if ((++sp & 255u) == 0u) { if (xb_ld(&bar[XB_TMO])) break; if (sp > XB_SPIN_CAP) { atomicAdd(&bar[XB_TMO], 1u); break; } }
    }
    nloc = mine > 0u ? mine : 1u; nx = cnt > 0u ? cnt : 1u;
}
__device__ __forceinline__ void xcd_barrier(const XcdBarrier& b) {
    asm volatile("s_waitcnt vmcnt(0)" ::: "memory");
    __syncthreads();
    if (threadIdx.x == 0) {
        unsigned* bar = b.bar;
        __builtin_amdgcn_s_waitcnt(0);
        unsigned nloc = b.st[0], nx = b.st[1];
        if (nloc == 0u) { xcd_barrier_complete(bar, b.x, nloc, nx); b.st[0] = nloc; b.st[1] = nx; }
        const unsigned old = xb_add(&bar[XB_XSUB(b.x)], 1u);
        const unsigned gen = old / nloc;
        if (old + 1u == (gen + 1u) * nloc) {
            __builtin_amdgcn_fence(__ATOMIC_RELEASE, "agent");
            asm volatile("s_waitcnt vmcnt(0)" ::: "memory");
            const unsigned og = xb_add(&bar[XB_TOP], 1u);
            const unsigned tg = og / nx;
            if (og + 1u == (tg + 1u) * nx) xb_add(&bar[XB_TOPGEN], 1u);
            else XB_SPIN(xb_ld(&bar[XB_TOPGEN]) == tg, bar);
            __builtin_amdgcn_fence(__ATOMIC_ACQUIRE, "agent");
            xb_add(&bar[XB_XGEN(b.x)], 1u);
            asm volatile("s_waitcnt vmcnt(0)" ::: "memory");
        } else {
            XB_SPIN(xb_ld(&bar[XB_XGEN(b.x)]) == gen, bar);
            __builtin_amdgcn_fence(__ATOMIC_ACQUIRE, "agent");
            asm volatile("s_waitcnt vmcnt(0)" ::: "memory");
        }
    }
    __syncthreads();
}

__device__ __forceinline__ float wave_sum(float v) {
#pragma unroll
    for (int o = 1; o < 64; o <<= 1) v += __shfl_xor(v, o);
    return v;
}

template <int MAP> __device__ __forceinline__ int dst_row(int n) {
    if (MAP == 1) {
        if (n < 384) return n;
        if (n < 640) return Z_KV + (n - 384);
        if (n < 704) { const int j = n - 640; return Z_KPE + (j < 32 ? 2 * j : 2 * (j - 32) + 1); }
        return Z_GATE + (n - 704);
    }
    if (MAP == 2) {
        const int h = n / 192, d = n % 192; if (d < 128) return n; const int j = d - 128; return h * 192 + 128 + (j < 32 ? 2 * j : 2 * (j - 32) + 1);
    }
    if (MAP == 3) {
        if (n < 2048) { const int c = n & 1023, isb = n >> 10; return 256 * (c >> 7) + 2 * (c & 127) + isb; }
        return n;
    }
    return n;
}
template <int MAP>
__device__ __forceinline__ void p0_transpose_item(const float* W, int K, int N, bf16u* WT, const float* gain, LAS float* scr, int item, int lane) {
    const int nblk = N / 32, kb = item / nblk, nb = item % nblk, k0 = 64 * kb, n0 = 32 * nb;
    float wv[32];
#pragma unroll
    for (int i = 0; i < 32; ++i) { const int kk = 2 * i + (lane >> 5); wv[i] = W[(size_t)(k0 + kk) * N + n0 + (lane & 31)]; }
#pragma unroll
    for (int i = 0; i < 32; ++i) { const int kk = 2 * i + (lane >> 5); const float gk = gain ? gain[k0 + kk] : 1.f; scr[kk * 33 + (lane & 31)] = wv[i] * gk; }
    LDS_WAIT(); asm volatile("" ::: "memory");
    const int c = lane & 7;
#pragma unroll
    for (int j = 0; j < 4; ++j) { const int n = (lane >> 3) + 8 * j; const LAS float* s = scr + (8 * c) * 33 + n;
        v4u o; o.x = pk2(s[0 * 33], s[1 * 33]); o.y = pk2(s[2 * 33], s[3 * 33]); o.z = pk2(s[4 * 33], s[5 * 33]); o.w = pk2(s[6 * 33], s[7 * 33]);
        *(GAS v4u*)(WT + (size_t)dst_row<MAP>(n0 + n) * K + k0 + 8 * c) = o; }
    LDS_WAIT(); asm volatile("" ::: "memory");
}

__constant__ float c_inv_freq[32] = {
    1.0f, 0.7498942093324559f, 0.5623413251903491f, 0.4216965034285822f, 0.31622776601683794f, 0.23713737056616552f, 0.1778279410038923f, 0.1333521432163324f,
    0.1f, 0.07498942093324558f, 0.05623413251903491f, 0.04216965034285822f, 0.03162277660168379f, 0.023713737056616554f, 0.01778279410038923f, 0.01333521432163324f,
    0.01f, 0.007498942093324558f, 0.005623413251903491f, 0.004216965034285823f, 0.0031622776601683794f, 0.0023713737056616554f, 0.0017782794100389228f, 0.001333521432163324f,
    0.001f, 0.0007498942093324559f, 0.0005623413251903491f, 0.00042169650342858224f, 0.00031622776601683794f, 0.00023713737056616554f, 0.00017782794100389227f, 0.0001333521432163324f };


#ifndef PROBE_KIND
#define PROBE_KIND -1
#endif
struct Args { const void* in[19]; float* out; unsigned char* ws; int lo, hi; };
typedef __amdgpu_buffer_rsrc_t rsrc_t;

#define DPP_ADD(v, ctrl, rmask) v += __builtin_bit_cast(float, __builtin_amdgcn_update_dpp(0, __builtin_bit_cast(int, v), ctrl, rmask, 0xF, false))
__device__ __forceinline__ float wave_sum_to_lane63(float v) {
    DPP_ADD(v, 0xB1, 0xF); DPP_ADD(v, 0x4E, 0xF); DPP_ADD(v, 0x141, 0xF); DPP_ADD(v, 0x140, 0xF); DPP_ADD(v, 0x142, 0xA); DPP_ADD(v, 0x143, 0xC);
    return v;
}
#undef DPP_ADD
__device__ __forceinline__ void conv_phase(rsrc_t rs, const float* dw_w, const float* dw_b, const float* ln_g, const float* ln_b, int vcu, int G, LAS unsigned char* lds) {
    const int tid = pg8::opaque((int)threadIdx.x), lane = tid & 63, wid = __builtin_amdgcn_readfirstlane(tid >> 6);
    const int c = 2 * tid; const unsigned vo = (unsigned)tid * 4u;
    const rsrc_t rw = __builtin_amdgcn_make_buffer_rsrc((void*)dw_w, 0, CONV_K * 1024 * 4, 0x00020000);
    f32x2 wk[CONV_K];
#pragma unroll
    for (int k = 0; k < CONV_K; ++k) wk[k] = __builtin_bit_cast(f32x2, __builtin_amdgcn_raw_buffer_load_b64(rw, vo * 2u, (unsigned)(k * 4096), 0));
    const f32x2 db = *(const f32x2*)(dw_b + c), lg = *(const f32x2*)(ln_g + c), lb = *(const f32x2*)(ln_b + c);
    LAS float* red = (LAS float*)lds;
    LAS float* stat = (LAS float*)(lds + 4096);
#define SOFF(base_, row_) ((unsigned)__builtin_amdgcn_readfirstlane((int)((unsigned)(base_) + (unsigned)(row_) * 2048u)))
    for (int tile = vcu; tile < MTOK / 32; tile += G) {
        const int b = tile >> 6, t0 = (tile & 63) * 32; const unsigned rowbase = (unsigned)b * SEQ;
#define CONV_LD(r_) __builtin_amdgcn_raw_buffer_load_b32(rs, vo, SOFF(WS_U, rowbase + (unsigned)((t0 - 30 + (r_)) < 0 ? 0 : (t0 - 30 + (r_)))), 0)
        f32x2 av[32];
#pragma unroll
        for (int t = 0; t < 32; ++t) av[t] = (f32x2){0.f, 0.f};
        unsigned ucur[8], unxt[8];
#pragma unroll
        for (int i = 0; i < 8; ++i) ucur[i] = CONV_LD(i);
#pragma unroll
        for (int g = 0; g < 8; ++g) {
#pragma unroll
            for (int i = 0; i < 8; ++i) { const int r = (g + 1) * 8 + i; unxt[i] = (r < 62) ? CONV_LD(r) : 0u; }
            asm volatile("" ::: "memory"); __builtin_amdgcn_sched_barrier(0);
#pragma unroll
            for (int i = 0; i < 8; ++i) { const int r = g * 8 + i;
                if (r < 62) { const unsigned uv = (t0 - 30 + r < 0) ? 0u : ucur[i];
                    const f32x2 u2 = {__uint_as_float(uv << 16), __uint_as_float(uv & 0xffff0000u)};
#pragma unroll
                    for (int t = 0; t < 32; ++t) { const int k = r - t; if (k >= 0 && k < CONV_K) av[t] = __builtin_elementwise_fma(wk[k], u2, av[t]); } } }
#pragma unroll
            for (int i = 0; i < 8; ++i) ucur[i] = unxt[i];
        }
#undef CONV_LD
        __builtin_amdgcn_sched_barrier(0);
        unsigned gv[32];
#pragma unroll
        for (int t = 0; t < 32; ++t) gv[t] = __builtin_amdgcn_raw_buffer_load_b32(rs, vo, SOFF(WS_G, rowbase + (unsigned)(t0 + t)), 0);
        asm volatile("" ::: "memory"); __builtin_amdgcn_sched_barrier(0);
#pragma unroll
        for (int t = 0; t < 32; ++t) {
            av[t] += db;
            const float s1 = wave_sum_to_lane63(av[t].x + av[t].y), s2 = wave_sum_to_lane63(av[t].x * av[t].x + av[t].y * av[t].y);
            if (lane == 63) *(LAS f32x2*)(red + (t * 8 + wid) * 2) = (f32x2){s1, s2};
            if ((t & 3) == 3) __builtin_amdgcn_sched_barrier(0);
        }
        LDS_WAIT(); __syncthreads();
        if (tid < 32) { float s1 = 0.f, s2 = 0.f;
#pragma unroll
            for (int w = 0; w < 8; ++w) { const f32x2 p = *(const LAS f32x2*)(red + (tid * 8 + w) * 2); s1 += p.x; s2 += p.y; }
            const float mean = s1 * (1.f / 1024.f), var = s2 * (1.f / 1024.f) - mean * mean;
            *(LAS f32x2*)(stat + tid * 2) = (f32x2){mean, rsqrtf(var + LN_EPS)}; }
        LDS_WAIT(); __syncthreads();
#pragma unroll
        for (int t = 0; t < 32; ++t) {
            const f32x2 st = *(const LAS f32x2*)(stat + t * 2);
            const float y0 = (av[t].x - st.x) * st.y * lg.x + lb.x, y1 = (av[t].y - st.x) * st.y * lg.y + lb.y;
            const float o0 = pg8::silu_f(y0) * __uint_as_float(gv[t] << 16), o1 = pg8::silu_f(y1) * __uint_as_float(gv[t] & 0xffff0000u);
            __builtin_amdgcn_raw_buffer_store_b32(pg8::cvt_pk_bf16(o0, o1), rs, vo, SOFF(WS_OA, rowbase + (unsigned)(t0 + t)), 0);
            if ((t & 7) == 7) __builtin_amdgcn_sched_barrier(0);
        }
        LDS_WAIT(); __syncthreads();
    }
#undef SOFF
}

__device__ __forceinline__ attn::BlockRef attn_mkref(int Lq, int pass) {
    const int bh = Lq >> 2, xq = Lq & 3, b = bh >> 3, h = bh & 7, qb = pass ? 7 - xq : xq;
    const unsigned r0 = (unsigned)b * SEQ, rq = r0 + (unsigned)qb * 256;
    attn::BlockRef R;
    R.q = (unsigned)WS_Q + (rq * QP + h * 192) * 2u; R.kn = (unsigned)WS_KV + (r0 * KVP + h * 256) * 2u;
    R.kp = (unsigned)WS_ZM + (r0 * ZP + Z_KPE) * 2u; R.o = (unsigned)WS_OA + (rq * 1024 + h * 128) * 2u; R.P0 = qb * 256;
    return R;
}

enum { K_PRO = 0, K_MIN = 1, K_Q = 2, K_KV = 3, K_ATT = 4, K_OUT = 5, K_CIN = 6, K_CMID = 7, K_FIN = 8 };
template <int KIND>
__device__ __forceinline__ void phase(const Args& args, int j, bool last_out, bool is_conv, unsigned char* lds, bool dup = false) {
    LAS unsigned char* L = (LAS unsigned char*)lds;
    const int tid = pg8::opaque((int)threadIdx.x), lane = tid & 63, wave = __builtin_amdgcn_readfirstlane(tid >> 6);
    int G = gridDim.x, bx = blockIdx.x; unsigned char* ws = args.ws;
    asm volatile("" : "+s"(G), "+s"(bx), "+s"(ws));
    const int vcu = (G % 8 == 0) ? (bx % 8) * (G / 8) + bx / 8 : bx;
    const int gw = vcu * NWAVES + wave, NGW = G * NWAVES;
    float* SSQ = (float*)(ws + WS_SSQ); float* SSQL = (float*)(ws + WS_SSQL);
    float* COS = (float*)(ws + WS_COS); float* SIN = (float*)(ws + WS_SIN);
    if constexpr (KIND == K_PRO) {
        const float* x_in = (const float*)args.in[0]; bf16u* XB = (bf16u*)(ws + WS_XB);
        LAS float* scr = (LAS float*)(L + RING_OFF + wave * 16384);
        constexpr int I_MIN = 16 * (MLA_IN / 32), I_QB = 6 * (QP / 32), I_KVB = 4 * (KVP / 32), I_O = 16 * 32, I_CIN = 16 * (CONV_IN / 32);
        constexpr int PER = I_MIN + I_QB + I_KVB + I_O + I_CIN + I_O;
        for (int it = gw; it < 2 * PER; it += NGW) {
            const int jj = it / PER; int r = it % PER;
            if (r < I_MIN) { p0_transpose_item<1>((const float*)args.in[4] + (size_t)jj * 1024 * MLA_IN, 1024, MLA_IN, (bf16u*)(ws + WS_WINM + jj * SZ_WINM), (const float*)args.in[3] + jj * 1024, scr, r, lane); continue; } r -= I_MIN;
            if (r < I_QB) { p0_transpose_item<2>((const float*)args.in[6] + (size_t)jj * Q_LORA * QP, Q_LORA, QP, (bf16u*)(ws + WS_WQB + jj * SZ_WQB), (const float*)args.in[5] + jj * Q_LORA, scr, r, lane); continue; } r -= I_QB;
            if (r < I_KVB) { p0_transpose_item<0>((const float*)args.in[8] + (size_t)jj * KV_LORA * KVP, KV_LORA, KVP, (bf16u*)(ws + WS_WKVB + jj * SZ_WKVB), (const float*)args.in[7] + jj * KV_LORA, scr, r, lane); continue; } r -= I_KVB;
            if (r < I_O) { p0_transpose_item<0>((const float*)args.in[9] + (size_t)jj * 1024 * 1024, 1024, 1024, (bf16u*)(ws + WS_WOM + jj * SZ_WO), nullptr, scr, r, lane); continue; } r -= I_O;
            if (r < I_CIN) { p0_transpose_item<3>((const float*)args.in[11] + (size_t)jj * 1024 * CONV_IN, 1024, CONV_IN, (bf16u*)(ws + WS_WINC + jj * SZ_WINC), (const float*)args.in[10] + jj * 1024, scr, r, lane); continue; } r -= I_CIN;
            p0_transpose_item<0>((const float*)args.in[17] + (size_t)jj * 1024 * 1024, 1024, 1024, (bf16u*)(ws + WS_WOC + jj * SZ_WO), nullptr, scr, r, lane);
        }
        for (int i = gw * 64 + lane; i < 2 * 64 * 128; i += NGW * 64) { const int jj = i / (64 * 128), rr = (i / 128) % 64, cc = i % 128;
            unsigned z = 0u; asm volatile("" : "+v"(z));
            *(GAS v4u*)(ws + WS_WINM + jj * SZ_WINM + (size_t)(448 + rr) * 2048 + cc * 16) = (v4u){z, z, z, z}; }
        for (int m0 = gw * 4; m0 < MTOK; m0 += NGW * 4) {
            f32x4 v[4][4]; float ss[4];
#pragma unroll
            for (int i = 0; i < 4; ++i) { const GAS f32x4* xr = (const GAS f32x4*)(x_in + (size_t)(m0 + i) * 1024) + lane;
#pragma unroll
                for (int q = 0; q < 4; ++q) v[i][q] = xr[64 * q]; }
#pragma unroll
            for (int i = 0; i < 4; ++i) { float s_ = 0.f;
#pragma unroll
                for (int q = 0; q < 4; ++q) s_ += (v[i][q].x * v[i][q].x + v[i][q].y * v[i][q].y) + (v[i][q].z * v[i][q].z + v[i][q].w * v[i][q].w);
                ss[i] = wave_sum(s_); }
#pragma unroll
            for (int i = 0; i < 4; ++i) { GAS unsigned long long* o8 = (GAS unsigned long long*)(XB + (size_t)(m0 + i) * 1024) + lane;
#pragma unroll
                for (int q = 0; q < 4; ++q) o8[64 * q] = (unsigned long long)pk2(v[i][q].x, v[i][q].y) | ((unsigned long long)pk2(v[i][q].z, v[i][q].w) << 32);
                if (lane == 0) *(f32x4*)(SSQ + (size_t)(m0 + i) * 4) = (f32x4){ss[i], 0.f, 0.f, 0.f}; }
        }
        const int* pos = (const int*)args.in[1];
        for (int i = gw * 64 + lane; i < MTOK * 32; i += NGW * 64) {
            const int m = i >> 5, fi = i & 31;
            const float ang = (float)pos[m] * c_inv_freq[fi];
            const double rev = (double)ang * 0.15915494309189535; const float fr = (float)(rev - __builtin_rint(rev));
            COS[i] = __builtin_amdgcn_cosf(fr); SIN[i] = __builtin_amdgcn_sinf(fr);
        }
    }
    if constexpr (KIND == K_FIN) {
        const float* gfin = (const float*)args.in[2]; float* xo = dup ? (float*)(ws + WS_KV) : args.out; const bf16u* XB = (const bf16u*)(ws + WS_XB);
        for (int m0 = gw * 2; m0 < MTOK; m0 += NGW * 2) {
            v4u xv[2][2]; f32x4 sx[2];
#pragma unroll
            for (int i = 0; i < 2; ++i) { sx[i] = *(const f32x4*)(SSQ + (size_t)(m0 + i) * 4);
#pragma unroll
                for (int q = 0; q < 2; ++q) xv[i][q] = *((const GAS v4u*)(XB + (size_t)(m0 + i) * 1024) + lane + 64 * q); }
#pragma unroll
            for (int i = 0; i < 2; ++i) {
                const float rstd = rsqrtf(((sx[i][0] + sx[i][1]) + (sx[i][2] + sx[i][3])) * (1.0f / 1024.0f) + RMS_EPS);
                GAS f32x4* xw = (GAS f32x4*)(xo + (size_t)(m0 + i) * 1024);
#pragma unroll
                for (int q = 0; q < 2; ++q) { const int e0 = (lane + 64 * q) * 2;
                    const f32x4 g0 = *((const f32x4*)gfin + e0), g1 = *((const f32x4*)gfin + e0 + 1); const v4u w = xv[i][q];
                    f32x4 a = {__uint_as_float(w.x << 16), __uint_as_float(w.x & 0xffff0000u), __uint_as_float(w.y << 16), __uint_as_float(w.y & 0xffff0000u)};
                    f32x4 b = {__uint_as_float(w.z << 16), __uint_as_float(w.z & 0xffff0000u), __uint_as_float(w.w << 16), __uint_as_float(w.w & 0xffff0000u)};
                    xw[e0] = a * rstd * g0; xw[e0 + 1] = b * rstd * g1; }
            }
        }
    }
    if constexpr (KIND == K_MIN) {
        pg8::Gemm g{(const bf16u*)(ws + WS_XB), (const bf16u*)(ws + WS_WINM + j * SZ_WINM), MTOK, ZN, 1024, 1024}; pg8::StaticOrder S; S.init(MTOK, ZN, G, bx);
        pg8::EpiMlaIn E{(bf16u*)(ws + WS_ZM), (bf16u*)(ws + WS_OA), SSQ, SSQL, COS, SIN};
        pg8::gemm_phase<pg8::EpiMlaIn, pg8::StaticOrder, true, true>(L + RING_OFF, g, S, E);
    }
    if constexpr (KIND == K_Q) {
        pg8::Gemm g{(const bf16u*)(ws + WS_ZM), (const bf16u*)(ws + WS_WQB + j * SZ_WQB), MTOK, QP, Q_LORA, ZP}; pg8::StaticOrder S; S.init(MTOK, QP, G, bx);
        pg8::EpiQ E{(bf16u*)(ws + WS_Q), SSQL, COS, SIN};
        pg8::gemm_phase<pg8::EpiQ, pg8::StaticOrder, true, true>(L + RING_OFF, g, S, E);
    }
    if constexpr (KIND == K_KV) {
        pg8::Gemm g{(const bf16u*)(ws + WS_ZM) + Z_KV, (const bf16u*)(ws + WS_WKVB + j * SZ_WKVB), MTOK, KVP, KV_LORA, ZP}; pg8::StaticOrder S; S.init(MTOK, KVP, G, bx);
        pg8::EpiKV E{(bf16u*)(ws + WS_KV), SSQL};
        pg8::gemm_phase<pg8::EpiKV, pg8::StaticOrder, true, true>(L + RING_OFF, g, S, E);
    }
    if constexpr (KIND == K_ATT) {
        const rsrc_t rs = __builtin_amdgcn_make_buffer_rsrc((void*)ws, 0, (unsigned)WS_END, 0x00020000);
        attn::Seam SM; bool primed = false;
        attn::BlockRef cur{};
        for (int Lq = vcu; Lq < 256; Lq += G) {
            for (int pass = 0; pass < 2; ++pass) {
                if (!primed) { cur = attn_mkref(Lq, pass); attn::attn_prime(cur, rs, (char*)lds, SM); primed = true; }
                const bool last = (pass == 1) && (Lq + G >= 256);
                const attn::BlockRef nxt = last ? cur : (pass == 0 ? attn_mkref(Lq, 1) : attn_mkref(Lq + G, 0));
                attn::attn_block(cur, nxt, rs, (char*)lds, SM);
                cur = nxt;
            }
        }
        asm volatile("s_waitcnt vmcnt(0)" ::: "memory"); __syncthreads();
    }
    if constexpr (KIND == K_OUT) {
        const bf16u* Wt = (const bf16u*)(ws + (is_conv ? WS_WOC : WS_WOM) + j * SZ_WO);
        pg8::Gemm g{(const bf16u*)(ws + WS_OA), Wt, MTOK, 1024, 1024, 1024}; pg8::StaticOrder S; S.init(MTOK, 1024, G, bx);
        pg8::EpiResid E{(const bf16u*)(ws + WS_XB), (bf16u*)(ws + (dup ? WS_KV : WS_XB)), nullptr, dup ? SSQL : SSQ, is_conv ? (const float*)args.in[18] + j * 1024 : nullptr};
        pg8::gemm_phase<pg8::EpiResid, pg8::StaticOrder, false, true>(L + RING_OFF, g, S, E);
    }
    if constexpr (KIND == K_CIN) {
        pg8::Gemm g{(const bf16u*)(ws + WS_XB), (const bf16u*)(ws + WS_WINC + j * SZ_WINC), MTOK, CONV_IN, 1024, 1024}; pg8::StaticOrder S; S.init(MTOK, CONV_IN, G, bx);
        pg8::EpiConvIn E{(bf16u*)(ws + WS_U), (bf16u*)(ws + WS_G), SSQ, (const float*)args.in[12] + j * CONV_IN};
        pg8::gemm_phase<pg8::EpiConvIn, pg8::StaticOrder, true, true>(L + RING_OFF, g, S, E);
    }
    if constexpr (KIND == K_CMID) {
        const rsrc_t rs = __builtin_amdgcn_make_buffer_rsrc((void*)ws, 0, (unsigned)WS_END, 0x00020000);
        conv_phase(rs, (const float*)args.in[13] + j * CONV_K * 1024, (const float*)args.in[14] + j * 1024, (const float*)args.in[15] + j * 1024, (const float*)args.in[16] + j * 1024, vcu, G, L + RING_OFF);
    }
}

#if MK_STEPWISE
template <int KIND>
__global__ void __launch_bounds__(NWAVES * 64, 2) step_kernel(Args args) {
    extern __shared__ __attribute__((aligned(16))) unsigned char lds[];
    const int s = args.lo, r7 = (s - 1) % 7, j = (s - 1) / 7;
    phase<KIND>(args, j, s == NSTEPS - 2, r7 == 6, lds);
}
template <int KIND> static void launch_step(Args a, int s, int grid, hipStream_t stream) {
    static bool done = false;
    if (!done) { done = true; (void)hipFuncSetAttribute((const void*)step_kernel<KIND>, hipFuncAttributeMaxDynamicSharedMemorySize, LDS_BYTES); }
    a.lo = s; a.hi = s + 1;
    hipLaunchKernelGGL(step_kernel<KIND>, dim3(grid), dim3(NWAVES * 64), LDS_BYTES, stream, a);
}
#else
__global__ void __launch_bounds__(NWAVES * 64, 2) trunk_fwd(Args args) {
    extern __shared__ __attribute__((aligned(16))) unsigned char lds[];
    volatile LAS unsigned* MISC = (volatile LAS unsigned*)((LAS unsigned char*)lds + MISC_OFF);
    if (threadIdx.x < 32) MISC[threadIdx.x] = 0u;
    __syncthreads();
    XcdBarrier bar = xcd_barrier_post((unsigned*)(args.ws + WS_CTL) + CW_BAR, MISC + 8);
    for (int s = args.lo; s < args.hi; ++s) {
        const int r7 = (s - 1) % 7, j = (s - 1) / 7;
#define RUNP(K, ...) do { if (PROBE_KIND == (K)) { phase<K>(__VA_ARGS__, true); } phase<K>(__VA_ARGS__); } while (0)
        if (s == 0) RUNP(K_PRO, args, 0, false, false, lds);
        else if (s == NSTEPS - 1) RUNP(K_FIN, args, 0, false, false, lds);
        else if (r7 == 0) RUNP(K_MIN, args, j, false, false, lds);
        else if (r7 == 1) { RUNP(K_Q, args, j, false, false, lds); RUNP(K_KV, args, j, false, false, lds); }
        else if (r7 == 2) RUNP(K_ATT, args, j, false, false, lds);
        else if (r7 == 3 || r7 == 6) RUNP(K_OUT, args, j, s == NSTEPS - 2, r7 == 6, lds);
        else if (r7 == 4) RUNP(K_CIN, args, j, false, false, lds);
        else RUNP(K_CMID, args, j, false, false, lds);
#undef RUNP
        if (s + 1 < args.hi) { xcd_barrier(bar); if (PROBE_KIND == 9) xcd_barrier(bar); }
    }
}
#endif

extern "C" void kernel_launch(void* const* d_in, const int* in_sizes, int n_in, void* d_out, int out_size, void* d_ws, size_t ws_size, hipStream_t stream) {
    static int grid = 0;
    if (grid == 0) {
        if (n_in != 19 || in_sizes[0] != MTOK * D_MODEL || out_size != MTOK * D_MODEL || ws_size < WS_END) {
            fprintf(stderr, "kernel_launch: unexpected shapes (n_in %d, in0 %d, out %d, ws %zu); nothing launched\n", n_in, n_in > 0 ? in_sizes[0] : -1, out_size, ws_size); grid = -1; return; }
        int dev = 0, cus = 0;
        if (hipGetDevice(&dev) != hipSuccess || hipDeviceGetAttribute(&cus, hipDeviceAttributeMultiprocessorCount, dev) != hipSuccess) { grid = -1; return; }
#if !MK_STEPWISE
        int per_cu = 0;
        if (hipFuncSetAttribute((const void*)trunk_fwd, hipFuncAttributeMaxDynamicSharedMemorySize, LDS_BYTES) != hipSuccess) { fprintf(stderr, "kernel_launch: hipFuncSetAttribute failed\n"); grid = -1; return; }
        if (hipOccupancyMaxActiveBlocksPerMultiprocessor(&per_cu, (const void*)trunk_fwd, NWAVES * 64, LDS_BYTES) != hipSuccess || per_cu < 1) { fprintf(stderr, "kernel_launch: occupancy query says %d blocks per CU\n", per_cu); (void)hipGetLastError(); }
#endif
        grid = cus;
    }
    if (grid < 0) return;
    Args a{};
    for (int i = 0; i < 19; ++i) a.in[i] = d_in[i];
    a.out = (float*)d_out; a.ws = (unsigned char*)d_ws;
#if MK_STEPWISE
    for (int s = 0; s < NSTEPS; ++s) {
        const int r7 = (s - 1) % 7;
        if (s == 0) launch_step<K_PRO>(a, s, grid, stream);
        else if (s == NSTEPS - 1) launch_step<K_FIN>(a, s, grid, stream);
        else if (r7 == 0) launch_step<K_MIN>(a, s, grid, stream);
        else if (r7 == 1) { launch_step<K_Q>(a, s, grid, stream); launch_step<K_KV>(a, s, grid, stream); }
        else if (r7 == 2) launch_step<K_ATT>(a, s, grid, stream);
        else if (r7 == 3 || r7 == 6) launch_step<K_OUT>(a, s, grid, stream);
        else if (r7 == 4) launch_step<K_CIN>(a, s, grid, stream);
        else launch_step<K_CMID>(a, s, grid, stream);
    }
#else
    if (hipMemsetAsync((char*)d_ws + WS_CTL, 0, CTL_ZERO_BYTES, stream) != hipSuccess) return;
    a.lo = 0; a.hi = NSTEPS;
    hipLaunchKernelGGL(trunk_fwd, dim3(grid), dim3(NWAVES * 64), LDS_BYTES, stream, a);
    const hipError_t e = hipPeekAtLastError();
    if (e != hipSuccess) fprintf(stderr, "kernel_launch: launch failed: %s (grid %d)\n", hipGetErrorString(e), grid);
#endif
}
```
